# Optimizing an MI355X kernel written in HIP

```python
import math
import jax, jax.numpy as jnp
from jax import lax
import numpy as np

D_MODEL = 1024
BATCH = 8
SEQ = 4096
DEPTH = 1

N_HEADS = 8
N_KV = 2
HEAD_DIM = 64
HPG = N_HEADS // N_KV
NSA_WIDTH = N_HEADS * HEAD_DIM
KV_WIDTH = N_KV * HEAD_DIM
ROPE_DIM = HEAD_DIM // 4
ROPE_THETA = 500000.0
CMP_BLOCK = 32
CMP_STRIDE = 16
SLC_BLOCK = 64
N_SLC = 16
WINDOW = 512
Q_BLOCK = 128
PHI_HIDDEN = 256
N_BRANCH = 3
LRU_WIDTH = D_MODEL
LRU_BLOCKS = 8
LRU_BD = LRU_WIDTH // LRU_BLOCKS
LRU_C = 8.0
CONV_W = 4
D_FF = 4 * D_MODEL
EPS = 1e-6
NEG = -1e30
FORCE_SCORE = 1e4
COL_WIDTHS = (NSA_WIDTH,) + (KV_WIDTH,) * 6 + (N_BRANCH * N_HEADS, LRU_WIDTH, LRU_WIDTH, 2 * D_MODEL)
IN_COLS = sum(COL_WIDTHS)

kernel_name = "hybrid_nsa_rglru_sqrelu_block"


def rmsnorm(x, w):
    xf = x.astype(jnp.float32)
    y = xf * lax.rsqrt(jnp.mean(xf * xf, axis=-1, keepdims=True) + EPS)
    return (y * w.astype(jnp.float32)).astype(x.dtype)


def rope_partial(x, pos):
    half = ROPE_DIM // 2
    inv = ROPE_THETA ** (-jnp.arange(half, dtype=jnp.float32) / half)
    ang = pos.astype(jnp.float32)[:, None] * inv[None, :]
    cos, sin = jnp.cos(ang), jnp.sin(ang)
    xr = x[..., :ROPE_DIM].astype(jnp.float32)
    x1, x2 = xr[..., :half], xr[..., half:]
    rot = jnp.concatenate([x1 * cos - x2 * sin, x2 * cos + x1 * sin], axis=-1).astype(x.dtype)
    return jnp.concatenate([rot, x[..., ROPE_DIM:]], axis=-1)


def kv_heads(t):
    b, s, _ = t.shape
    return t.reshape(b, s, N_KV, HEAD_DIM).transpose(0, 2, 1, 3)


def compress_mlp(blocks, pos_emb, w1, w2):
    z = (blocks + pos_emb).reshape(blocks.shape[:3] + (CMP_BLOCK * HEAD_DIM,))
    return jax.nn.gelu(z @ w1) @ w2


def nsa_mixer(q_raw, kc_raw, vc_raw, ks_raw, vs_raw, kw_raw, vw_raw, g_raw,
              q_norm_w, k_norm_w, phi_k_pos, phi_k_w1, phi_k_w2, phi_v_pos, phi_v_w1, phi_v_w2):
    B, S, _ = q_raw.shape
    dt = q_raw.dtype
    scale = HEAD_DIM ** -0.5
    t = jnp.arange(S, dtype=jnp.int32)
    nqb = S // Q_BLOCK

    q = q_raw.reshape(B, S, N_KV, HPG, HEAD_DIM).transpose(0, 2, 3, 1, 4)
    q = rope_partial(rmsnorm(q, q_norm_w), t)

    n_cmp = (S - CMP_BLOCK) // CMP_STRIDE + 1
    cmp_idx = jnp.arange(n_cmp)[:, None] * CMP_STRIDE + jnp.arange(CMP_BLOCK)[None, :]
    cmp_end = cmp_idx[:, -1]
    kc = compress_mlp(kv_heads(kc_raw)[:, :, cmp_idx], phi_k_pos, phi_k_w1, phi_k_w2)
    vc = compress_mlp(kv_heads(vc_raw)[:, :, cmp_idx], phi_v_pos, phi_v_w1, phi_v_w2)
    kc = rope_partial(rmsnorm(kc, k_norm_w[0]), cmp_end)
    s_c = jnp.einsum('bghsd,bgnd->bghsn', q, kc).astype(jnp.float32) * scale
    mask_c = cmp_end[None, :] <= t[:, None]
    p_c = jax.nn.softmax(jnp.where(mask_c, s_c, NEG), axis=-1)
    p_c = jnp.where((t >= CMP_BLOCK - 1)[:, None], p_c, 0.0)
    o_cmp = jnp.einsum('bghsn,bgnd->bghsd', p_c.astype(dt), vc)

    n_slc = S // SLC_BLOCK
    n_sel = min(N_SLC, n_slc)
    blk = jnp.arange(n_slc)
    slc_lo = blk * SLC_BLOCK
    overlap = ((cmp_idx[:, 0][:, None] <= (slc_lo + SLC_BLOCK - 1)[None, :]) &
               (cmp_end[:, None] >= slc_lo[None, :])).astype(jnp.float32)
    imp = jnp.einsum('bghsn,nj->bgsj', p_c, overlap)
    cur = t // SLC_BLOCK
    forced = (blk[None, :] == 0) | (blk[None, :] == cur[:, None]) | (blk[None, :] == cur[:, None] - 1)
    causal_ok = blk[None, :] <= cur[:, None]
    score = jnp.where(causal_ok, jnp.where(forced, FORCE_SCORE, imp), NEG)
    _, sel = lax.top_k(score, n_sel)

    k_s = rope_partial(rmsnorm(kv_heads(ks_raw), k_norm_w[1]), t)
    v_s = kv_heads(vs_raw)
    b_ix = jnp.arange(B)[:, None, None]
    g_ix = jnp.arange(N_KV)[None, :, None]
    q_blk = q.reshape(B, N_KV, HPG, nqb, Q_BLOCK, HEAD_DIM).transpose(3, 0, 1, 2, 4, 5)
    sel_blk = sel.reshape(B, N_KV, nqb, Q_BLOCK, n_sel).transpose(2, 0, 1, 3, 4)
    t_blk = t.reshape(nqb, Q_BLOCK)

    def attend_selected(args):
        qb, sb, tb = args
        tok = sb[..., None] * SLC_BLOCK + jnp.arange(SLC_BLOCK)
        tok = tok.reshape(B, N_KV, Q_BLOCK * n_sel * SLC_BLOCK)
        kg = k_s[b_ix, g_ix, tok].reshape(B, N_KV, Q_BLOCK, n_sel * SLC_BLOCK, HEAD_DIM)
        vg = v_s[b_ix, g_ix, tok].reshape(B, N_KV, Q_BLOCK, n_sel * SLC_BLOCK, HEAD_DIM)
        s = jnp.einsum('bghqd,bgqkd->bghqk', qb, kg).astype(jnp.float32) * scale
        m = tok.reshape(B, N_KV, Q_BLOCK, n_sel * SLC_BLOCK) <= tb[None, None, :, None]
        p = jax.nn.softmax(jnp.where(m[:, :, None], s, NEG), axis=-1)
        return jnp.einsum('bghqk,bgqkd->bghqd', p.astype(dt), vg)

    o_slc = lax.map(attend_selected, (q_blk, sel_blk, t_blk))
    o_slc = o_slc.transpose(1, 2, 3, 0, 4, 5).reshape(B, N_KV, HPG, S, HEAD_DIM)

    k_w = rope_partial(rmsnorm(kv_heads(kw_raw), k_norm_w[2]), t)
    v_w = kv_heads(vw_raw)
    win_pos = jnp.arange(nqb)[:, None] * Q_BLOCK + jnp.arange(WINDOW + Q_BLOCK)[None, :] - WINDOW
    safe = jnp.clip(win_pos, 0, S - 1)
    kb = k_w[:, :, safe]
    vb = v_w[:, :, safe]
    qw = q.reshape(B, N_KV, HPG, nqb, Q_BLOCK, HEAD_DIM)
    s_w = jnp.einsum('bghnqd,bgnkd->bghnqk', qw, kb).astype(jnp.float32) * scale
    kp = win_pos[:, None, :]
    tq = t_blk[:, :, None]
    mask_w = (kp <= tq) & (kp > tq - WINDOW) & (kp >= 0)
    p_w = jax.nn.softmax(jnp.where(mask_w, s_w, NEG), axis=-1)
    o_win = jnp.einsum('bghnqk,bgnkd->bghnqd', p_w.astype(dt), vb).reshape(B, N_KV, HPG, S, HEAD_DIM)

    g = jax.nn.sigmoid(g_raw).reshape(B, S, N_BRANCH, N_KV, HPG).transpose(2, 0, 3, 4, 1)[..., None]
    o = g[0] * o_cmp + g[1] * o_slc + g[2] * o_win
    return o.transpose(0, 3, 1, 2, 4).reshape(B, S, NSA_WIDTH)


def rglru_mixer(xr, yr, conv_w, conv_b, lru_wa, lru_ba, lru_wx, lru_bx, lru_lambda):
    B, S, W = xr.shape
    xp = jnp.pad(xr, ((0, 0), (CONV_W - 1, 0), (0, 0)))
    xc = conv_b + sum(xp[:, j:j + S] * conv_w[j] for j in range(CONV_W))
    xb = xc.reshape(B, S, LRU_BLOCKS, LRU_BD)
    r = jax.nn.sigmoid(jnp.einsum('bsnd,nde->bsne', xb, lru_wa) + lru_ba).reshape(B, S, W)
    i_g = jax.nn.sigmoid(jnp.einsum('bsnd,nde->bsne', xb, lru_wx) + lru_bx).reshape(B, S, W)
    log_a = -LRU_C * jax.nn.softplus(-lru_lambda.astype(jnp.float32)) * r.astype(jnp.float32)
    a = jnp.exp(log_a)
    bterm = jnp.sqrt(-jnp.expm1(2.0 * log_a)) * (i_g.astype(jnp.float32) * xc.astype(jnp.float32))

    def combine(left, right):
        a1, b1 = left
        a2, b2 = right
        return a1 * a2, a2 * b1 + b2

    _, h = lax.associative_scan(combine, (a, bterm), axis=1)
    return h.astype(xr.dtype) * jax.nn.gelu(yr)


def setup_inputs(seed: int = 0) -> dict:
    key = jax.random.key(seed)
    ks = jax.random.split(key, 24)
    L = DEPTH

    def nrm(k, shape, scale):
        return jax.random.normal(k, shape, jnp.float32) * scale

    u = jax.random.uniform(ks[17], (L, LRU_WIDTH), jnp.float32, 0.9, 0.999)
    a0 = u ** (1.0 / LRU_C)
    return {
        "x": nrm(ks[0], (BATCH, SEQ, D_MODEL), 1.0),
        "norm1_w": 1.0 + nrm(ks[1], (L, D_MODEL), 0.02),
        "w_in": nrm(ks[2], (L, D_MODEL, IN_COLS), D_MODEL ** -0.5),
        "q_norm_w": 1.0 + nrm(ks[3], (L, HEAD_DIM), 0.02),
        "k_norm_w": 1.0 + nrm(ks[4], (L, N_BRANCH, HEAD_DIM), 0.02),
        "phi_k_pos": nrm(ks[5], (L, CMP_BLOCK, HEAD_DIM), 0.02),
        "phi_k_w1": nrm(ks[6], (L, CMP_BLOCK * HEAD_DIM, PHI_HIDDEN), (CMP_BLOCK * HEAD_DIM) ** -0.5),
        "phi_k_w2": nrm(ks[7], (L, PHI_HIDDEN, HEAD_DIM), PHI_HIDDEN ** -0.5),
        "phi_v_pos": nrm(ks[8], (L, CMP_BLOCK, HEAD_DIM), 0.02),
        "phi_v_w1": nrm(ks[9], (L, CMP_BLOCK * HEAD_DIM, PHI_HIDDEN), (CMP_BLOCK * HEAD_DIM) ** -0.5),
        "phi_v_w2": nrm(ks[10], (L, PHI_HIDDEN, HEAD_DIM), PHI_HIDDEN ** -0.5),
        "conv_w": nrm(ks[11], (L, CONV_W, LRU_WIDTH), CONV_W ** -0.5),
        "conv_b": nrm(ks[12], (L, LRU_WIDTH), 0.01),
        "lru_wa": nrm(ks[13], (L, LRU_BLOCKS, LRU_BD, LRU_BD), LRU_BD ** -0.5),
        "lru_ba": nrm(ks[14], (L, LRU_BLOCKS, LRU_BD), 0.01),
        "lru_wx": nrm(ks[15], (L, LRU_BLOCKS, LRU_BD, LRU_BD), LRU_BD ** -0.5),
        "lru_bx": nrm(ks[16], (L, LRU_BLOCKS, LRU_BD), 0.01),
        "lru_lambda": jnp.log(a0) - jnp.log1p(-a0),
        "w_nsa_up": nrm(ks[18], (L, NSA_WIDTH, D_MODEL), NSA_WIDTH ** -0.5),
        "w_lru_up": nrm(ks[19], (L, LRU_WIDTH, D_MODEL), LRU_WIDTH ** -0.5),
        "w_o": nrm(ks[20], (L, D_MODEL, D_MODEL), D_MODEL ** -0.5),
        "norm2_w": 1.0 + nrm(ks[21], (L, D_MODEL), 0.02),
        "w_ff1": nrm(ks[22], (L, D_MODEL, D_FF), D_MODEL ** -0.5),
        "w_ff2": nrm(ks[23], (L, D_FF, D_MODEL), D_FF ** -0.5),
    }


def reference(x, norm1_w, w_in, q_norm_w, k_norm_w, phi_k_pos, phi_k_w1, phi_k_w2,
              phi_v_pos, phi_v_w1, phi_v_w2, conv_w, conv_b, lru_wa, lru_ba, lru_wx, lru_bx,
              lru_lambda, w_nsa_up, w_lru_up, w_o, norm2_w, w_ff1, w_ff2):
    h = x
    for l in range(DEPTH):
        xn = rmsnorm(h, norm1_w[l])
        proj = xn @ w_in[l]
        parts = []
        off = 0
        for wdt in COL_WIDTHS:
            parts.append(proj[..., off:off + wdt])
            off += wdt
        q_raw, kc_raw, vc_raw, ks_raw, vs_raw, kw_raw, vw_raw, g_nsa, xr, yr, g_merge = parts

        o_nsa = nsa_mixer(q_raw, kc_raw, vc_raw, ks_raw, vs_raw, kw_raw, vw_raw, g_nsa,
                          q_norm_w[l], k_norm_w[l], phi_k_pos[l], phi_k_w1[l], phi_k_w2[l],
                          phi_v_pos[l], phi_v_w1[l], phi_v_w2[l])
        o_lru = rglru_mixer(xr, yr, conv_w[l], conv_b[l], lru_wa[l], lru_ba[l], lru_wx[l],
                            lru_bx[l], lru_lambda[l])
        gate = jax.nn.sigmoid(g_merge)
        merged = gate[..., :D_MODEL] * (o_nsa @ w_nsa_up[l]) + gate[..., D_MODEL:] * (o_lru @ w_lru_up[l])
        h = h + merged @ w_o[l]

        hn = rmsnorm(h, norm2_w[l])
        h = h + jnp.square(jax.nn.relu(hn @ w_ff1[l])) @ w_ff2[l]
    return h
```

```cpp
#include <hip/hip_runtime.h>
#include <cstdio>
#include <cstdint>
#define MK_N_LAUNCHES 1
#define DI __device__ __forceinline__
constexpr int NWAVES = 8;
constexpr int BATCH = 8, SEQ = 4096, DM = 1024, T = BATCH * SEQ;
constexpr int NPROJ = 5632, DFF = 4096;
constexpr size_t MiB = 1u << 20;
constexpr size_t WS_CTL = 0, CTL_ZERO_BYTES = 1 * MiB;
constexpr size_t WS_SS = 256 * 1024;
constexpr size_t WS_TAB = 1 * MiB;
constexpr size_t WS_WIN = 2 * MiB, WS_WNU = 13 * MiB, WS_WLU = 14 * MiB, WS_WO = 16 * MiB, WS_W1 = 18 * MiB, WS_W2 = 26 * MiB;
constexpr size_t WS_PK1 = 34 * MiB, WS_PV1 = 35 * MiB, WS_PK2 = 36 * MiB, WS_PV2 = 36 * MiB + 64 * 1024, WS_LWA = 36 * MiB + 128 * 1024, WS_LWX = 36 * MiB + 384 * 1024;
constexpr size_t WS_KC = 37 * MiB, WS_VC = 37 * MiB + 512 * 1024, WS_GN = 38 * MiB;
constexpr size_t WS_XN = 40 * MiB, WS_Q = 104 * MiB, WS_KV = 136 * MiB, WS_XR = 184 * MiB, WS_YR = 248 * MiB, WS_GM = 312 * MiB, WS_ONSA = 440 * MiB, WS_END = 472 * MiB;
constexpr size_t WS_OL = WS_XN, WS_HB = WS_XN, WS_MERGED = WS_XR, WS_U = WS_Q;
constexpr int CW_TMO = 0, CW_CODE = 1, CW_BAR = 4096;
constexpr int RING_OFF = 0, RING_BYTES = 131072;
constexpr int LDSCTL_OFF = RING_BYTES, MISC_OFF = LDSCTL_OFF + 320;
constexpr int LDS_BYTES = 147456;
namespace pg8 {
#define PG8_LAS __attribute__((address_space(3)))
typedef unsigned short bf16_t;
typedef short bf16x8 __attribute__((ext_vector_type(8)));
typedef float f32x4 __attribute__((ext_vector_type(4)));
typedef unsigned u32x4 __attribute__((ext_vector_type(4)));
constexpr int BM = 256, BK = 64, HALF = 128, HTB = HALF * BK * 2  , STAGE_BYTES = 8 * HTB, NXCD = 8, WGM = 8;

__host__ __device__ __forceinline__ int lds_byte(int r, int c) { const int st = (r >> 4) * 2 + (c >> 5), rr = r & 15, cc = c & 31, ob = rr * 64 + cc * 2; return st * 1024 + (ob ^ (((ob >> 9) & 1) << 5)); }
__host__ __device__ __forceinline__ void stage_rc(int b, int& R, int& C) { const int st = b / 1024, sb = b % 1024, swz = sb ^ (((sb >> 9) & 1) << 5); R = (st >> 1) * 16 + swz / 64; C = (st & 1) * 32 + (swz % 64) / 2; }
__host__ __device__ __forceinline__ int perm32(int rho) { const int n = rho >> 4, i = rho & 15; return 8 * (i >> 2) + 4 * n + (i & 3); }

struct Unit { int pm, pn; };
struct Gemm { const bf16_t* A; const bf16_t* Bt; int M, N, K; };

struct StaticOrder {
    int nM, nN, nwg, G, c;
    __host__ __device__ void init(int M, int N, int G_, int c_) { nM = M / BM; nN = N / BM; nwg = nM * nN; G = G_; c = c_; }
    __host__ __device__ bool next(int i, Unit& u) const {
        const long L = (long)i * G + c; if (L >= nwg) return false;
        int wgid = (int)L; { const int q = nwg / NXCD, r = nwg % NXCD, xcd = wgid % NXCD, off = wgid / NXCD; wgid = (xcd < r ? xcd * (q + 1) : r * (q + 1) + (xcd - r) * q) + off; }
        const int nig = WGM * nN, gid = wgid / nig, fm = gid * WGM, gsz = (nM - fm) < WGM ? (nM - fm) : WGM;
        u.pm = fm + ((wgid % nig) % gsz); u.pn = (wgid % nig) / gsz; return true;
    }
    __device__ __forceinline__ void a_ready(const Unit&) const {}
    __device__ __forceinline__ void done(const Unit&) const {}
};

__device__ __forceinline__ unsigned cvt_pk_bf16(float lo, float hi) { unsigned r; asm volatile("v_cvt_pk_bf16_f32 %0, %1, %2" : "=v"(r) : "v"(lo), "v"(hi)); return r; }
typedef float f32x2 __attribute__((ext_vector_type(2)));
typedef unsigned u32x2 __attribute__((ext_vector_type(2)));
__device__ __forceinline__ float bf_lo(unsigned w) { return __uint_as_float(w << 16); }
__device__ __forceinline__ float bf_hi(unsigned w) { return __uint_as_float(w & 0xffff0000u); }
__device__ __forceinline__ float sigm(float x) { return __builtin_amdgcn_rcpf(1.0f + __expf(-x)); }
__device__ __forceinline__ u32x4 pack8(const f32x4 v0, const f32x4 v1) { u32x4 w; w.x = cvt_pk_bf16(v0[0], v0[1]); w.y = cvt_pk_bf16(v0[2], v0[3]); w.z = cvt_pk_bf16(v1[0], v1[1]); w.w = cvt_pk_bf16(v1[2], v1[3]); return w; }

struct EpiProj {
    static constexpr bool PERM = true, AFTER_DRAIN = false;
    unsigned char* ws;
    __device__ __forceinline__ void operator()(const f32x4 (&acc)[2][2][4][2], const Unit& u, int wr, int wc, int fr, int fq) const {
        const int pn = u.pn; size_t boff; int ldc, colt;
        if (pn < 2) { boff = ::WS_Q; ldc = 512; colt = pn * 256; }
        else if (pn < 5) { boff = ::WS_KV; ldc = 768; colt = (pn - 2) * 256; }
        else if (pn < 9) { boff = ::WS_XR; ldc = 1024; colt = (pn - 5) * 256; }
        else if (pn < 13) { boff = ::WS_YR; ldc = 1024; colt = (pn - 9) * 256; }
        else if (pn < 21) { boff = ::WS_GM; ldc = 2048; colt = (pn - 13) * 256; }
        else { boff = ::WS_GN; ldc = 32; colt = 0; }
        bf16_t* base = (bf16_t*)(ws + boff);
        const int row0 = u.pm * BM + wr * 64 + fr, col0 = colt + wc * 32 + 8 * fq;
        const bool narrow = (pn == 21);
        if (narrow && wc != 0) return;
#pragma unroll
        for (int ai = 0; ai < 2; ++ai)
#pragma unroll
            for (int m = 0; m < 4; ++m) { bf16_t* rowp = base + (size_t)(row0 + ai * HALF + m * 16) * ldc + col0;
#pragma unroll
                for (int bj = 0; bj < 2; ++bj) { if (narrow && bj) continue; *(u32x4*)(rowp + bj * HALF) = pack8(acc[ai][bj][m][0], acc[ai][bj][m][1]); } }
    }
};
struct EpiMerge {
    static constexpr bool PERM = true, AFTER_DRAIN = false;
    const bf16_t* GM; bf16_t* O; int second;
    __device__ __forceinline__ void operator()(const f32x4 (&acc)[2][2][4][2], const Unit& u, int wr, int wc, int fr, int fq) const {
        const int row0 = u.pm * BM + wr * 64 + fr, col0 = u.pn * BM + wc * 32 + 8 * fq;
#pragma unroll
        for (int ai = 0; ai < 2; ++ai)
#pragma unroll
            for (int m = 0; m < 4; ++m) { const size_t row = (size_t)(row0 + ai * HALF + m * 16);
#pragma unroll
                for (int bj = 0; bj < 2; ++bj) { const int col = col0 + bj * HALF;
                    const u32x4 gv = *(const u32x4*)(GM + row * 2048 + second * 1024 + col);
                    f32x4 v0 = acc[ai][bj][m][0], v1 = acc[ai][bj][m][1];
                    v0[0] *= sigm(bf_lo(gv.x)); v0[1] *= sigm(bf_hi(gv.x)); v0[2] *= sigm(bf_lo(gv.y)); v0[3] *= sigm(bf_hi(gv.y));
                    v1[0] *= sigm(bf_lo(gv.z)); v1[1] *= sigm(bf_hi(gv.z)); v1[2] *= sigm(bf_lo(gv.w)); v1[3] *= sigm(bf_hi(gv.w));
                    if (second) { const u32x4 tv = *(const u32x4*)(O + row * 1024 + col);
                        v0[0] += bf_lo(tv.x); v0[1] += bf_hi(tv.x); v0[2] += bf_lo(tv.y); v0[3] += bf_hi(tv.y);
                        v1[0] += bf_lo(tv.z); v1[1] += bf_hi(tv.z); v1[2] += bf_lo(tv.w); v1[3] += bf_hi(tv.w); }
                    *(u32x4*)(O + row * 1024 + col) = pack8(v0, v1); } }
    }
};
struct EpiWo {
    static constexpr bool PERM = false, AFTER_DRAIN = false;
    const float* X; float* H; bf16_t* HB; float* SS;
    __device__ __forceinline__ void operator()(const f32x4 (&acc)[2][2][4][2], const Unit& u, int wr, int wc, int fr, int fq) const {
        const int row0 = u.pm * BM + wr * 64 + fr, col0 = u.pn * BM + wc * 32 + 4 * fq;
#pragma unroll
        for (int ai = 0; ai < 2; ++ai)
#pragma unroll
            for (int m = 0; m < 4; ++m) { const int row = row0 + ai * HALF + m * 16; float ss = 0.f;
#pragma unroll
                for (int bj = 0; bj < 2; ++bj)
#pragma unroll
                    for (int n = 0; n < 2; ++n) { const size_t off = (size_t)row * 1024 + col0 + bj * HALF + n * 16;
                        const f32x4 h = *(const f32x4*)(X + off) + acc[ai][bj][m][n];
                        *(f32x4*)(H + off) = h; ss += (h[0] * h[0] + h[1] * h[1]) + (h[2] * h[2] + h[3] * h[3]);
                        u32x2 w; w.x = cvt_pk_bf16(h[0], h[1]); w.y = cvt_pk_bf16(h[2], h[3]); *(u32x2*)(HB + off) = w; }
                ss += __shfl_xor(ss, 16); ss += __shfl_xor(ss, 32);
                if (fq == 0) atomicAdd(SS + row, ss); }
    }
};
struct EpiFF1 {
    static constexpr bool PERM = true, AFTER_DRAIN = false;
    const float* SS; bf16_t* U;
    __device__ __forceinline__ void operator()(const f32x4 (&acc)[2][2][4][2], const Unit& u, int wr, int wc, int fr, int fq) const {
        const int row0 = u.pm * BM + wr * 64 + fr, col0 = u.pn * BM + wc * 32 + 8 * fq;
#pragma unroll
        for (int ai = 0; ai < 2; ++ai)
#pragma unroll
            for (int m = 0; m < 4; ++m) { const int row = row0 + ai * HALF + m * 16; const float sc = rsqrtf(SS[row] * (1.0f / 1024.0f) + 1e-6f);
#pragma unroll
                for (int bj = 0; bj < 2; ++bj) { f32x4 v0 = acc[ai][bj][m][0] * sc, v1 = acc[ai][bj][m][1] * sc;
#pragma unroll
                    for (int i = 0; i < 4; ++i) { const float a = fmaxf(v0[i], 0.f), b = fmaxf(v1[i], 0.f); v0[i] = a * a; v1[i] = b * b; }
                    *(u32x4*)(U + (size_t)row * 4096 + col0 + bj * HALF) = pack8(v0, v1); } }
    }
};
struct EpiFF2 {
    static constexpr bool PERM = false, AFTER_DRAIN = false;
    float* H;
    __device__ __forceinline__ void operator()(const f32x4 (&acc)[2][2][4][2], const Unit& u, int wr, int wc, int fr, int fq) const {
        const int row0 = u.pm * BM + wr * 64 + fr, col0 = u.pn * BM + wc * 32 + 4 * fq;
#pragma unroll
        for (int ai = 0; ai < 2; ++ai)
#pragma unroll
            for (int m = 0; m < 4; ++m) { const int row = row0 + ai * HALF + m * 16;
#pragma unroll
                for (int bj = 0; bj < 2; ++bj)
#pragma unroll
                    for (int n = 0; n < 2; ++n) { const size_t off = (size_t)row * 1024 + col0 + bj * HALF + n * 16;
                        *(f32x4*)(H + off) = *(const f32x4*)(H + off) + acc[ai][bj][m][n]; } }
    }
};
template <class Epi, class Sched, bool ALIGN_EPI = false, bool SP2 = false>
__device__ __forceinline__ void gemm_phase(PG8_LAS unsigned char* lds, const Gemm g, const Sched& S, const Epi& E) {
    const int tid = threadIdx.x, wid = __builtin_amdgcn_readfirstlane(tid >> 6), lane = tid & 63, wr = wid >> 2, wc = wid & 3, fr = lane & 15, fq = lane >> 4;
    const int K = g.K, nt = K / BK;
    unsigned voffA[2], voffB[2];
#pragma unroll
    for (int i = 0; i < 2; ++i) { int R, C; stage_rc(tid * 16 + i * 8192, R, C); const int Rb = Epi::PERM ? ((R & ~31) + perm32(R & 31)) : R;
        voffA[i] = (unsigned)(R * K + C) * 2u; voffB[i] = (unsigned)(Rb * K + C) * 2u; }
    const size_t kstep = (size_t)(BK * 2);
    const size_t hstep = (size_t)HALF * K * 2;
    const size_t tstep = 2 * hstep;
    const unsigned ldsw = (unsigned)wid * 1024u;
    const int aoff = lds_byte(wr * 64 + fr, fq * 8), boff = lds_byte(wc * 32 + fr, fq * 8);
#define PG8_SA(b, h) (((b) * 2 + (h)) * HTB)
#define PG8_SB(b, h) ((4 + (b) * 2 + (h)) * HTB)
#define PG8_STAGE(bufoff, gbase, voff) do { _Pragma("unroll") for (int _i = 0; _i < 2; ++_i) \
        __builtin_amdgcn_global_load_lds((const unsigned*)((const char*)(gbase) + (voff)[_i]), (PG8_LAS unsigned*)(lds + (bufoff) + ldsw + _i * 8192), 16, 0, 0); } while (0)
#define PG8_LDA(dst, b, h) do { _Pragma("unroll") for (int m = 0; m < 4; ++m) _Pragma("unroll") for (int k = 0; k < 2; ++k) dst[m][k] = *(const PG8_LAS bf16x8*)(lds + PG8_SA(b, h) + aoff + m * 2048 + k * 1024); } while (0)
#define PG8_LDB(dst, b, h) do { _Pragma("unroll") for (int n = 0; n < 2; ++n) _Pragma("unroll") for (int k = 0; k < 2; ++k) dst[n][k] = *(const PG8_LAS bf16x8*)(lds + PG8_SB(b, h) + boff + n * 2048 + k * 1024); } while (0)
#define PG8_MMA(ai, bj, At, Bt) do { __builtin_amdgcn_s_setprio(1); _Pragma("unroll") for (int m = 0; m < 4; ++m) _Pragma("unroll") for (int n = 0; n < 2; ++n) _Pragma("unroll") for (int k = 0; k < 2; ++k) \
        acc[ai][bj][m][n] = __builtin_amdgcn_mfma_f32_16x16x32_bf16(Bt[n][k], At[m][k], acc[ai][bj][m][n], 0, 0, 0); __builtin_amdgcn_s_setprio(0); } while (0)
#define PG8_WAIT_V(n) asm volatile("s_waitcnt vmcnt(" #n ")" ::: "memory")
#define PG8_WAIT_L(n) asm volatile("s_waitcnt lgkmcnt(" #n ")" ::: "memory")
#define PG8_BAR __builtin_amdgcn_s_barrier()
#define PG8_SCHED __builtin_amdgcn_sched_barrier(0)
    Unit cur, nxt; int ui = 0;
    if (!S.next(0, cur)) return;
    f32x4 acc[2][2][4][2];
#pragma unroll
    for (int a = 0; a < 2; ++a)
#pragma unroll
        for (int b = 0; b < 2; ++b)
#pragma unroll
            for (int m = 0; m < 4; ++m)
#pragma unroll
                for (int n = 0; n < 2; ++n) acc[a][b][m][n] = (f32x4){0.f, 0.f, 0.f, 0.f};
    bf16x8 At[4][2], B0[2][2], B1[2][2];
    const char* cA = (const char*)g.A + (size_t)cur.pm * tstep; const char* cB = (const char*)g.Bt + (size_t)cur.pn * tstep;
    S.a_ready(cur);
    if constexpr (SP2) {
        PG8_STAGE(PG8_SB(0, 0), cB, voffB); PG8_STAGE(PG8_SB(0, 1), cB + hstep, voffB); PG8_STAGE(PG8_SA(0, 0), cA, voffA); PG8_STAGE(PG8_SA(0, 1), cA + hstep, voffA);
        if (wr == 1) PG8_BAR;
        PG8_WAIT_V(2); PG8_BAR;
        PG8_STAGE(PG8_SB(1, 0), cB + kstep, voffB); PG8_STAGE(PG8_SA(1, 0), cA + kstep, voffA); PG8_STAGE(PG8_SB(1, 1), cB + hstep + kstep, voffB);
        PG8_WAIT_V(6); PG8_BAR;
    } else {
        PG8_STAGE(PG8_SB(0, 0), cB, voffB); PG8_STAGE(PG8_SA(0, 0), cA, voffA); PG8_STAGE(PG8_SB(0, 1), cB + hstep, voffB); PG8_STAGE(PG8_SA(0, 1), cA + hstep, voffA);
        if (wr == 1) PG8_BAR;
        PG8_WAIT_V(4); PG8_BAR;
        PG8_STAGE(PG8_SB(1, 0), cB + kstep, voffB); PG8_STAGE(PG8_SA(1, 0), cA + kstep, voffA); PG8_STAGE(PG8_SB(1, 1), cB + hstep + kstep, voffB);
        PG8_WAIT_V(6); PG8_BAR;
    }
    for (;;) {
        const bool has_next = S.next(ui + 1, nxt);
        const char* nA = has_next ? (const char*)g.A + (size_t)nxt.pm * tstep : cA; const char* nB = has_next ? (const char*)g.Bt + (size_t)nxt.pn * tstep : cB;
        for (int t = 0; t < nt; t += 2) {
            const bool last = (t == nt - 2);
            const char* a1 = cA + (size_t)(t + 1) * kstep;
            const char* a2 = last ? nA : cA + (size_t)(t + 2) * kstep; const char* b2 = last ? nB : cB + (size_t)(t + 2) * kstep;
            const char* a3 = a2 + kstep; const char* b3 = b2 + kstep;
            if (last && has_next) S.a_ready(nxt);
            if constexpr (SP2) {
            PG8_LDB(B0, 0, 0); PG8_LDB(B1, 0, 1); PG8_SCHED; PG8_LDA(At, 0, 0); PG8_STAGE(PG8_SA(1, 1), a1 + hstep, voffA);
            PG8_WAIT_V(8); PG8_WAIT_L(0); PG8_BAR; PG8_MMA(0, 0, At, B0); PG8_MMA(0, 1, At, B1); PG8_BAR; PG8_SCHED;
            PG8_LDA(At, 0, 1); PG8_STAGE(PG8_SB(0, 0), b2, voffB); PG8_STAGE(PG8_SB(0, 1), b2 + hstep, voffB); PG8_STAGE(PG8_SA(0, 0), a2, voffA);
            PG8_WAIT_V(8); PG8_WAIT_L(0); PG8_BAR; PG8_MMA(1, 0, At, B0); PG8_MMA(1, 1, At, B1); PG8_BAR; PG8_SCHED;
            PG8_LDB(B0, 1, 0); PG8_LDB(B1, 1, 1); PG8_SCHED; PG8_LDA(At, 1, 0); PG8_STAGE(PG8_SA(0, 1), a2 + hstep, voffA);
            PG8_WAIT_V(8); PG8_WAIT_L(0); PG8_BAR; PG8_MMA(0, 0, At, B0); PG8_MMA(0, 1, At, B1); PG8_BAR; PG8_SCHED;
            PG8_LDA(At, 1, 1); PG8_STAGE(PG8_SB(1, 0), b3, voffB); PG8_STAGE(PG8_SB(1, 1), b3 + hstep, voffB); PG8_STAGE(PG8_SA(1, 0), a3, voffA);
            PG8_WAIT_V(8); PG8_WAIT_L(0); PG8_BAR; PG8_MMA(1, 0, At, B0); PG8_MMA(1, 1, At, B1); PG8_BAR; PG8_SCHED;
            } else {
            PG8_LDB(B0, 0, 0); PG8_SCHED; PG8_LDA(At, 0, 0); PG8_STAGE(PG8_SA(1, 1), a1 + hstep, voffA);
            PG8_WAIT_L(8); PG8_BAR; PG8_WAIT_L(0); PG8_MMA(0, 0, At, B0); PG8_BAR; PG8_SCHED;
            PG8_LDB(B1, 0, 1); PG8_STAGE(PG8_SB(0, 0), b2, voffB);
            PG8_BAR; PG8_WAIT_L(0); PG8_MMA(0, 1, At, B1); PG8_BAR;
            PG8_LDA(At, 0, 1); PG8_STAGE(PG8_SA(0, 0), a2, voffA);
            PG8_BAR; PG8_WAIT_L(0); PG8_MMA(1, 0, At, B0); PG8_BAR; PG8_SCHED;
            PG8_STAGE(PG8_SB(0, 1), b2 + hstep, voffB);
            PG8_WAIT_V(6); PG8_BAR; PG8_MMA(1, 1, At, B1); PG8_BAR;
            PG8_LDB(B0, 1, 0); PG8_SCHED; PG8_LDA(At, 1, 0); PG8_STAGE(PG8_SA(0, 1), a2 + hstep, voffA);
            PG8_WAIT_L(8); PG8_BAR; PG8_WAIT_L(0); PG8_MMA(0, 0, At, B0); PG8_BAR; PG8_SCHED;
            PG8_LDB(B1, 1, 1); PG8_STAGE(PG8_SB(1, 0), b3, voffB);
            PG8_BAR; PG8_WAIT_L(0); PG8_MMA(0, 1, At, B1); PG8_BAR;
            PG8_LDA(At, 1, 1); PG8_STAGE(PG8_SA(1, 0), a3, voffA);
            PG8_BAR; PG8_WAIT_L(0); PG8_MMA(1, 0, At, B0); PG8_BAR; PG8_SCHED;
            PG8_STAGE(PG8_SB(1, 1), b3 + hstep, voffB);
            PG8_WAIT_V(6); PG8_BAR; PG8_MMA(1, 1, At, B1); PG8_BAR;
            }
        }
        if constexpr (ALIGN_EPI) { if (wr == 0) PG8_BAR; }
        if constexpr (!Epi::AFTER_DRAIN) { E(acc, cur, wr, wc, fr, fq); S.done(cur); }
        if (!has_next) break;
#pragma unroll
        for (int a = 0; a < 2; ++a)
#pragma unroll
            for (int b = 0; b < 2; ++b)
#pragma unroll
                for (int m = 0; m < 4; ++m)
#pragma unroll
                    for (int n = 0; n < 2; ++n) acc[a][b][m][n] = (f32x4){0.f, 0.f, 0.f, 0.f};
        cur = nxt; cA = nA; cB = nB; ++ui;
        if constexpr (ALIGN_EPI) { if (wr == 1) PG8_BAR; }
    }
    PG8_WAIT_V(0);
    if constexpr (!ALIGN_EPI) { if (wr == 0) PG8_BAR; }
    PG8_BAR;
    if constexpr (Epi::AFTER_DRAIN) { E.fused(acc, cur, wr, wc, fr, fq, lds, wid, lane); S.done(cur); }
#undef PG8_SA
#undef PG8_SB
#undef PG8_STAGE
#undef PG8_LDA
#undef PG8_LDB
#undef PG8_MMA
#undef PG8_WAIT_V
#undef PG8_WAIT_L
#undef PG8_BAR
#undef PG8_SCHED
}
}
#define GAS __attribute__((address_space(1)))
#define LAS __attribute__((address_space(3)))
typedef unsigned short bf16;
typedef unsigned v4u __attribute__((ext_vector_type(4)));
typedef float f32x4 __attribute__((ext_vector_type(4)));
typedef short bf16x8 __attribute__((ext_vector_type(8)));
typedef GAS unsigned gu32;
typedef GAS unsigned long long gu64;
#define RLX_AGENT __ATOMIC_RELAXED, __HIP_MEMORY_SCOPE_AGENT
#define LDS_WAIT() asm volatile("s_waitcnt lgkmcnt(0)" ::: "memory")
#define VM_WAIT() asm volatile("s_waitcnt vmcnt(0)" ::: "memory")
__device__ __forceinline__ unsigned long long rt() { return __builtin_amdgcn_s_memrealtime(); }
__device__ __forceinline__ unsigned f2bf(float f) { unsigned u = __builtin_bit_cast(unsigned, f); return (u + 0x7fffu + ((u >> 16) & 1u)) >> 16; }
__device__ __forceinline__ unsigned pk2(float lo, float hi) { return f2bf(lo) | (f2bf(hi) << 16); }
#define XB_TMO      128
#define XB_XCNT(j)  (256  + 64 * (j))
#define XB_XSUB(j)  (1280 + 64 * (j))
#define XB_XGEN(j)  (2304 + 64 * (j))
#define XB_TOP      3328
#define XB_TOPGEN   3392
#define XCD_BAR_WORDS 3456
#define XB_SPIN_CAP (1u << 18)

__device__ __forceinline__ unsigned xb_ld(unsigned* p)              { return __hip_atomic_load(p, __ATOMIC_RELAXED, __HIP_MEMORY_SCOPE_AGENT); }
__device__ __forceinline__ unsigned xb_add(unsigned* p, unsigned v) { return __hip_atomic_fetch_add(p, v, __ATOMIC_RELAXED, __HIP_MEMORY_SCOPE_AGENT); }
__device__ __forceinline__ unsigned xb_xcc_id() { return (unsigned)__builtin_amdgcn_s_getreg((3 << 11) | 20) & 0xFu; }
#define XB_SPIN(cond, bar) do { unsigned _sp = 0; while (cond) { __builtin_amdgcn_s_sleep(1); \
    if ((++_sp & 255u) == 0u) { if (xb_ld(&(bar)[XB_TMO])) break; if (_sp > XB_SPIN_CAP) { atomicAdd(&(bar)[XB_TMO], 1u); break; } } } } while (0)

struct XcdBarrier {
    unsigned* bar; unsigned x;
    volatile LAS unsigned* st;
};

__device__ __forceinline__ XcdBarrier xcd_barrier_post(unsigned* bar, volatile LAS unsigned* st) {
    XcdBarrier b; b.bar = bar; b.x = xb_xcc_id(); b.st = st;
    if (threadIdx.x == 0) (void)xb_add(&bar[XB_XCNT(b.x)], 1u);
    return b;
}
__device__ __forceinline__ void xcd_barrier_complete(unsigned* bar, unsigned x, unsigned& nloc, unsigned& nx) {
    const unsigned G = gridDim.x * gridDim.y * gridDim.z;
    unsigned sum, cnt, mine, sp = 0u;
    for (;;) {
        sum = 0u; cnt = 0u; mine = 0u;
#pragma unroll
        for (unsigned j = 0; j < 16; ++j) { const unsigned c = xb_ld(&bar[XB_XCNT(j)]); sum += c; cnt += (c > 0u) ? 1u : 0u; mine = (j == x) ? c : mine; }
        if (sum == G) break;
        __builtin_amdgcn_s_sleep(1);
        if ((++sp & 255u) == 0u) { if (xb_ld(&bar[XB_TMO])) break; if (sp > XB_SPIN_CAP) { atomicAdd(&bar[XB_TMO], 1u); break; } }
    }
    nloc = mine > 0u ? mine : 1u; nx = cnt > 0u ? cnt : 1u;
}

__device__ __forceinline__ void xcd_barrier(const XcdBarrier& b) {
    asm volatile("s_waitcnt vmcnt(0)" ::: "memory");
    __syncthreads();
    if (threadIdx.x == 0) {
        unsigned* bar = b.bar;
        __builtin_amdgcn_s_waitcnt(0);
        unsigned nloc = b.st[0], nx = b.st[1];
        if (nloc == 0u) { xcd_barrier_complete(bar, b.x, nloc, nx); b.st[0] = nloc; b.st[1] = nx; }
        const unsigned old = xb_add(&bar[XB_XSUB(b.x)], 1u);
        const unsigned gen = old / nloc;
        if (old + 1u == (gen + 1u) * nloc) {
            __builtin_amdgcn_fence(__ATOMIC_RELEASE, "agent");
            asm volatile("s_waitcnt vmcnt(0)" ::: "memory");
            const unsigned og = xb_add(&bar[XB_TOP], 1u);
            const unsigned tg = og / nx;
            if (og + 1u == (tg + 1u) * nx) xb_add(&bar[XB_TOPGEN], 1u);
            else XB_SPIN(xb_ld(&bar[XB_TOPGEN]) == tg, bar);
            __builtin_amdgcn_fence(__ATOMIC_ACQUIRE, "agent");
            xb_add(&bar[XB_XGEN(b.x)], 1u);
            asm volatile("s_waitcnt vmcnt(0)" ::: "memory");
        } else {
            XB_SPIN(xb_ld(&bar[XB_XGEN(b.x)]) == gen, bar);
            __builtin_amdgcn_fence(__ATOMIC_ACQUIRE, "agent");
            asm volatile("s_waitcnt vmcnt(0)" ::: "memory");
        }
    }
    __syncthreads();
}
typedef float f32x16 __attribute__((ext_vector_type(16)));
struct Ctx {
    const float* const* in; float* outp; unsigned char* ws;
    int tid, lane, wave, vcu, G;
    DI const float* x() const { return in[0]; }
    DI const float* norm1_w() const { return in[1]; }
    DI const float* w_in() const { return in[2]; }
    DI const float* q_norm_w() const { return in[3]; }
    DI const float* k_norm_w() const { return in[4]; }
    DI const float* phi_k_pos() const { return in[5]; }
    DI const float* phi_k_w1() const { return in[6]; }
    DI const float* phi_k_w2() const { return in[7]; }
    DI const float* phi_v_pos() const { return in[8]; }
    DI const float* phi_v_w1() const { return in[9]; }
    DI const float* phi_v_w2() const { return in[10]; }
    DI const float* conv_w() const { return in[11]; }
    DI const float* conv_b() const { return in[12]; }
    DI const float* lru_wa() const { return in[13]; }
    DI const float* lru_ba() const { return in[14]; }
    DI const float* lru_wx() const { return in[15]; }
    DI const float* lru_bx() const { return in[16]; }
    DI const float* lru_lambda() const { return in[17]; }
    DI const float* w_nsa_up() const { return in[18]; }
    DI const float* w_lru_up() const { return in[19]; }
    DI const float* w_o() const { return in[20]; }
    DI const float* norm2_w() const { return in[21]; }
    DI const float* w_ff1() const { return in[22]; }
    DI const float* w_ff2() const { return in[23]; }
    DI float* out() const { return outp; }
    DI float* SS() const { return (float*)(ws + WS_SS); }
    DI float* ROPE_C() const { return (float*)(ws + WS_TAB); }
    DI float* ROPE_S() const { return (float*)(ws + WS_TAB + 128 * 1024); }
    DI float* CLAM() const { return (float*)(ws + WS_TAB + 256 * 1024); }
    DI float* PHIB() const { return (float*)(ws + WS_TAB + 260 * 1024); }
    DI bf16* WIN() const { return (bf16*)(ws + WS_WIN); }
    DI bf16* WNU() const { return (bf16*)(ws + WS_WNU); }
    DI bf16* WLU() const { return (bf16*)(ws + WS_WLU); }
    DI bf16* WO() const { return (bf16*)(ws + WS_WO); }
    DI bf16* W1() const { return (bf16*)(ws + WS_W1); }
    DI bf16* W2() const { return (bf16*)(ws + WS_W2); }
    DI bf16* PK1() const { return (bf16*)(ws + WS_PK1); }
    DI bf16* PV1() const { return (bf16*)(ws + WS_PV1); }
    DI bf16* PK2() const { return (bf16*)(ws + WS_PK2); }
    DI bf16* PV2() const { return (bf16*)(ws + WS_PV2); }
    DI bf16* LWA() const { return (bf16*)(ws + WS_LWA); }
    DI bf16* LWX() const { return (bf16*)(ws + WS_LWX); }
    DI bf16* KC() const { return (bf16*)(ws + WS_KC); }
    DI bf16* VC() const { return (bf16*)(ws + WS_VC); }
    DI bf16* GN() const { return (bf16*)(ws + WS_GN); }
    DI bf16* XN() const { return (bf16*)(ws + WS_XN); }
    DI bf16* Q() const { return (bf16*)(ws + WS_Q); }
    DI bf16* KV() const { return (bf16*)(ws + WS_KV); }
    DI bf16* XR() const { return (bf16*)(ws + WS_XR); }
    DI bf16* YR() const { return (bf16*)(ws + WS_YR); }
    DI bf16* GM() const { return (bf16*)(ws + WS_GM); }
    DI bf16* ONSA() const { return (bf16*)(ws + WS_ONSA); }
    DI bf16* OL() const { return (bf16*)(ws + WS_OL); }
    DI bf16* HB() const { return (bf16*)(ws + WS_HB); }
    DI bf16* MERGED() const { return (bf16*)(ws + WS_MERGED); }
    DI bf16* U() const { return (bf16*)(ws + WS_U); }
};
DI float bf2f(bf16 h) { return __uint_as_float((unsigned)h << 16); }
DI float wave_sum(float v) {
#pragma unroll
    for (int o = 1; o < 64; o <<= 1) v += __shfl_xor(v, o);
    return v;
}
DI float wave_max(float v) {
#pragma unroll
    for (int o = 1; o < 64; o <<= 1) v = fmaxf(v, __shfl_xor(v, o));
    return v;
}
DI float sigm(float x) { return __builtin_amdgcn_rcpf(1.0f + __expf(-x)); }
DI float gelu_tanh(float x) { const float u = 0.7978845608028654f * (x + 0.044715f * x * x * x); const float t = 1.0f - 2.0f * __builtin_amdgcn_rcpf(__expf(2.0f * u) + 1.0f); return 0.5f * x * (1.0f + t); }
#define MFMA16(a, b, c) __builtin_amdgcn_mfma_f32_16x16x32_bf16((a), (b), (c), 0, 0, 0)

struct ColMapId { DI int operator()(int n) const { return n; } };
struct ColMapIn { DI int operator()(int n) const { return n < 1280 ? n : (n < 5376 ? n + 24 : (n < 5400 ? n - 4096 : -1)); } };
template <class CM> DI void transpose_item(const float* W, int ldsrc, const float* rowscale, bf16* WT, int K, int kb, int nb, CM cm, LAS float* scr, int lane) {
    const int k0 = 64 * kb, n0 = 32 * nb; const int c = cm(n0 + (lane & 31));
#pragma unroll 8
    for (int i = 0; i < 32; ++i) { const int kk = 2 * i + (lane >> 5); float v = (c >= 0) ? W[(size_t)(k0 + kk) * ldsrc + c] : 0.f; if (rowscale) v *= rowscale[k0 + kk]; scr[kk * 33 + (lane & 31)] = v; }
    LDS_WAIT(); asm volatile("" ::: "memory");
    const int cc = lane & 7;
#pragma unroll
    for (int j = 0; j < 4; ++j) { const int n = (lane >> 3) + 8 * j; const LAS float* s = scr + (8 * cc) * 33 + n;
        v4u o; o.x = pk2(s[0 * 33], s[1 * 33]); o.y = pk2(s[2 * 33], s[3 * 33]); o.z = pk2(s[4 * 33], s[5 * 33]); o.w = pk2(s[6 * 33], s[7 * 33]);
        *(GAS v4u*)(WT + (size_t)(n0 + n) * K + k0 + 8 * cc) = o; }
    LDS_WAIT(); asm volatile("" ::: "memory");
}
DI void sincos_acc(double x, float& s_out, float& c_out) {
    const double TWO_PI = 6.283185307179586476925286766559, INV_2PI = 0.15915494309189533576888376337251, PI = 3.1415926535897932384626433832795;
    const double k = rint(x * INV_2PI); double r = x - k * TWO_PI; double csign = 1.0;
    if (r > 0.5 * PI) { r = PI - r; csign = -1.0; } else if (r < -0.5 * PI) { r = -PI - r; csign = -1.0; }
    const double z = r * r;
    double sp = -1.0 / 121645100408832000.0;
    sp = sp * z + 1.0 / 355687428096000.0; sp = sp * z - 1.0 / 1307674368000.0; sp = sp * z + 1.0 / 6227020800.0; sp = sp * z - 1.0 / 39916800.0;
    sp = sp * z + 1.0 / 362880.0; sp = sp * z - 1.0 / 5040.0; sp = sp * z + 1.0 / 120.0; sp = sp * z - 1.0 / 6.0; sp = sp * z + 1.0;
    double cp = 1.0 / 2432902008176640000.0;
    cp = cp * z - 1.0 / 6402373705728000.0; cp = cp * z + 1.0 / 20922789888000.0; cp = cp * z - 1.0 / 87178291200.0; cp = cp * z + 1.0 / 479001600.0;
    cp = cp * z - 1.0 / 3628800.0; cp = cp * z + 1.0 / 40320.0; cp = cp * z - 1.0 / 720.0; cp = cp * z + 1.0 / 24.0; cp = cp * z - 0.5; cp = cp * z + 1.0;
    s_out = (float)(sp * r); c_out = (float)(csign * cp);
}
DI void p0_prologue(const Ctx& C, LAS unsigned char* lds) {
    LAS float* scr = (LAS float*)(lds + C.wave * 16384);
    const int gw = C.vcu * NWAVES + C.wave, NGW = C.G * NWAVES, lane = C.lane;
    constexpr int I_IN = 16 * 176, I_NU = 8 * 32, I_LU = 16 * 32, I_WO = 16 * 32, I_W1 = 16 * 128, I_W2 = 64 * 32, I_P1 = 32 * 8, I_P2 = 4 * 2, I_LW = 8 * 8;
    constexpr int NITEMS = I_IN + I_NU + I_LU + I_WO + I_W1 + I_W2 + 2 * I_P1 + 2 * I_P2 + 2 * I_LW;
    for (int it = gw; it < NITEMS; it += NGW) {
        int r = it;
        if (r < I_IN) { transpose_item(C.w_in(), 5400, nullptr, C.WIN(), 1024, r / 176, r % 176, ColMapIn(), scr, lane); continue; } r -= I_IN;
        if (r < I_NU) { transpose_item(C.w_nsa_up(), 1024, nullptr, C.WNU(), 512, r / 32, r % 32, ColMapId(), scr, lane); continue; } r -= I_NU;
        if (r < I_LU) { transpose_item(C.w_lru_up(), 1024, nullptr, C.WLU(), 1024, r / 32, r % 32, ColMapId(), scr, lane); continue; } r -= I_LU;
        if (r < I_WO) { transpose_item(C.w_o(), 1024, nullptr, C.WO(), 1024, r / 32, r % 32, ColMapId(), scr, lane); continue; } r -= I_WO;
        if (r < I_W1) { transpose_item(C.w_ff1(), 4096, C.norm2_w(), C.W1(), 1024, r / 128, r % 128, ColMapId(), scr, lane); continue; } r -= I_W1;
        if (r < I_W2) { transpose_item(C.w_ff2(), 1024, nullptr, C.W2(), 4096, r / 32, r % 32, ColMapId(), scr, lane); continue; } r -= I_W2;
        if (r < I_P1) { transpose_item(C.phi_k_w1(), 256, nullptr, C.PK1(), 2048, r / 8, r % 8, ColMapId(), scr, lane); continue; } r -= I_P1;
        if (r < I_P1) { transpose_item(C.phi_v_w1(), 256, nullptr, C.PV1(), 2048, r / 8, r % 8, ColMapId(), scr, lane); continue; } r -= I_P1;
        if (r < I_P2) { transpose_item(C.phi_k_w2(), 64, nullptr, C.PK2(), 256, r / 2, r % 2, ColMapId(), scr, lane); continue; } r -= I_P2;
        if (r < I_P2) { transpose_item(C.phi_v_w2(), 64, nullptr, C.PV2(), 256, r / 2, r % 2, ColMapId(), scr, lane); continue; } r -= I_P2;
        if (r < I_LW) { const int n = r >> 3, q = r & 7; transpose_item(C.lru_wa() + (size_t)n * 16384, 128, nullptr, C.LWA() + (size_t)n * 16384, 128, q >> 2, q & 3, ColMapId(), scr, lane); continue; } r -= I_LW;
        { const int n = r >> 3, q = r & 7; transpose_item(C.lru_wx() + (size_t)n * 16384, 128, nullptr, C.LWX() + (size_t)n * 16384, 128, q >> 2, q & 3, ColMapId(), scr, lane); }
    }
    {
        f32x4 wv[4];
#pragma unroll
        for (int j = 0; j < 4; ++j) wv[j] = ((const GAS f32x4*)C.norm1_w())[lane + 64 * j];
        for (int m = gw; m < T; m += NGW) {
            const GAS f32x4* xr = (const GAS f32x4*)(C.x() + (size_t)m * DM) + lane;
            f32x4 v[4]; float s = 0.f;
#pragma unroll
            for (int j = 0; j < 4; ++j) { v[j] = xr[64 * j]; s += (v[j].x * v[j].x + v[j].y * v[j].y) + (v[j].z * v[j].z + v[j].w * v[j].w); }
            const float rstd = rsqrtf(wave_sum(s) * (1.0f / DM) + 1e-6f);
            GAS unsigned long long* o8 = (GAS unsigned long long*)(C.XN() + (size_t)m * DM) + lane;
#pragma unroll
            for (int j = 0; j < 4; ++j) o8[64 * j] = (unsigned long long)pk2(v[j].x * rstd * wv[j].x, v[j].y * rstd * wv[j].y) | ((unsigned long long)pk2(v[j].z * rstd * wv[j].z, v[j].w * rstd * wv[j].w) << 32);
        }
    }
    {
        const int gt = C.vcu * (NWAVES * 64) + C.tid, NGT = C.G * NWAVES * 64;
        for (int e = gt; e < 4096 * 8 + 1024; e += NGT) {
            if (e < 4096 * 8) {
                const int pos = e >> 3, i = e & 7;
                const unsigned invb[8] = {0x3f800000u, 0x3e4693afu, 0x3d1a08c8u, 0x3beef74eu, 0x3ab95d22u, 0x398fc8f8u, 0x385f10c5u, 0x372d07a8u};
                unsigned ib = invb[0];
#pragma unroll
                for (int q = 1; q < 8; ++q) ib = (i == q) ? invb[q] : ib;
                const float ang = (float)pos * __uint_as_float(ib);
                float s, c; sincos_acc((double)ang, s, c); C.ROPE_S()[e] = s; C.ROPE_C()[e] = c;
            } else {
                const int ch = e - 4096 * 8; const float lam = C.lru_lambda()[ch]; const float xx = __expf(-lam);
                const float sp = (xx < 0.03f) ? xx * (1.0f - xx * (0.5f - xx * (0.33333333f - 0.25f * xx))) : __logf(1.0f + xx);
                C.CLAM()[ch] = -8.0f * sp;
            }
        }
    }
    for (int o = gw; o < 512; o += NGW) {
        const int kv = o >> 8, n = o & 255; const float* pos = kv ? C.phi_v_pos() : C.phi_k_pos(); const float* w1 = kv ? C.phi_v_w1() : C.phi_k_w1();
        float s = 0.f;
        for (int k = lane; k < 2048; k += 64) s += pos[k] * w1[(size_t)k * 256 + n];
        s = wave_sum(s);
        if (lane == 0) C.PHIB()[o] = s;
    }
}

DI void lru_strip(const Ctx& C, int strip, LAS unsigned char* lds) {
    const int tid = C.tid, lane = C.lane, wave = C.wave, l15 = lane & 15, lg = lane >> 4;
    const int b = strip >> 5, n = (strip >> 2) & 7, eq = strip & 3;
    LAS float* cw = (LAS float*)lds;
    LAS float* xch = (LAS float*)(lds + 4096);
    LAS bf16x8* wf = (LAS bf16x8*)(lds + 8192);
    for (int i = tid; i < 640; i += NWAVES * 64) cw[i] = (i < 512) ? C.conv_w()[(i >> 7) * 1024 + n * 128 + (i & 127)] : C.conv_b()[n * 128 + (i - 512)];
    for (int i = tid; i < 1024; i += NWAVES * 64) { const int fl = i & 63, fi = i >> 6, gate = fi >> 3, nt = (fi >> 2) & 1, ks = fi & 3;
        const size_t o = (size_t)(n * 128 + 32 * eq + 16 * nt + (fl & 15)) * 128 + 32 * ks + 8 * (fl >> 4);
        wf[i] = *(const bf16x8*)((gate ? C.LWX() : C.LWA()) + o); }
    __syncthreads();
    bf16x8 Id[2];
#pragma unroll
    for (int nt = 0; nt < 2; ++nt) {
#pragma unroll
        for (int j = 0; j < 8; ++j) Id[nt][j] = (8 * lg + j == 16 * nt + l15) ? (short)0x3F80 : (short)0;
    }
    float ba[2], bx[2], cl[2], hprev[2] = {0.f, 0.f};
#pragma unroll
    for (int nt = 0; nt < 2; ++nt) { const int ch = n * 128 + 32 * eq + 16 * nt + l15; ba[nt] = C.lru_ba()[ch]; bx[nt] = C.lru_bx()[ch]; cl[nt] = C.CLAM()[ch]; }
    const char* xbase = (const char*)(C.XR() + (size_t)b * SEQ * 1024 + n * 128);
    const char* ybase = (const char*)(C.YR() + (size_t)b * SEQ * 1024 + n * 128 + 32 * eq);
    char* obase = (char*)(C.OL() + (size_t)b * SEQ * 1024 + n * 128 + 32 * eq);
#pragma unroll 1
    for (int chunk = 0; chunk < 32; ++chunk) {
        const int s0 = chunk * 128 + wave * 16;
        int l15o = l15, lgo = lg; asm volatile("" : "+v"(l15o), "+v"(lgo));
        bf16x8 Af[4];
        v4u xa[4], xb[4];
#define LRU_LOADX(dst, ks_) do { _Pragma("unroll") for (int tp = 0; tp < 4; ++tp) { \
            const int sk = s0 + l15o - 3 + tp; v4u xv = *(const v4u*)(xbase + ((sk >= 0 ? sk : 0) * 2048 + 64 * (ks_) + 16 * lgo)); \
            if (sk < 0) xv = (v4u){0u, 0u, 0u, 0u}; dst[tp] = xv; } } while (0)
#define LRU_CONV(src, ks_) do { f32x4 w[5][2]; \
            _Pragma("unroll") for (int tp = 0; tp < 5; ++tp) { w[tp][0] = *(const LAS f32x4*)(cw + tp * 128 + 32 * (ks_) + 8 * lg); w[tp][1] = *(const LAS f32x4*)(cw + tp * 128 + 32 * (ks_) + 8 * lg + 4); } \
            f32x4 a0 = w[4][0], a1 = w[4][1]; \
            _Pragma("unroll") for (int tp = 0; tp < 4; ++tp) { const v4u xv = src[tp]; \
                a0[0] += w[tp][0][0] * __uint_as_float(xv.x << 16); a0[1] += w[tp][0][1] * __uint_as_float(xv.x & 0xffff0000u); \
                a0[2] += w[tp][0][2] * __uint_as_float(xv.y << 16); a0[3] += w[tp][0][3] * __uint_as_float(xv.y & 0xffff0000u); \
                a1[0] += w[tp][1][0] * __uint_as_float(xv.z << 16); a1[1] += w[tp][1][1] * __uint_as_float(xv.z & 0xffff0000u); \
                a1[2] += w[tp][1][2] * __uint_as_float(xv.w << 16); a1[3] += w[tp][1][3] * __uint_as_float(xv.w & 0xffff0000u); } \
            v4u pk; pk.x = pk2(a0[0], a0[1]); pk.y = pk2(a0[2], a0[3]); pk.z = pk2(a1[0], a1[1]); pk.w = pk2(a1[2], a1[3]); \
            Af[ks_] = __builtin_bit_cast(bf16x8, pk); } while (0)
#define LRU_FENCE() do { asm volatile("" ::: "memory"); __builtin_amdgcn_sched_barrier(0); } while (0)
#define LRU_PIN(ks_) asm volatile("" : "+v"(Af[ks_]) :: "memory")
        LRU_LOADX(xa, 0); LRU_LOADX(xb, 1); LRU_FENCE(); LRU_CONV(xa, 0); LRU_PIN(0);
        LRU_LOADX(xa, 2); LRU_FENCE(); LRU_CONV(xb, 1); LRU_PIN(1);
        LRU_LOADX(xb, 3); LRU_FENCE(); LRU_CONV(xa, 2); LRU_PIN(2);
        LRU_CONV(xb, 3); LRU_PIN(3);
#undef LRU_PIN
#undef LRU_LOADX
#undef LRU_CONV
        bf16 yv[2][4];
#pragma unroll
        for (int nt = 0; nt < 2; ++nt)
#pragma unroll
            for (int r = 0; r < 4; ++r) yv[nt][r] = *(const bf16*)(ybase + ((s0 + 4 * lgo + r) * 2048 + 32 * nt + 2 * l15o));
        LRU_FENCE();
        float Ap[2][4], Hp[2][4], Aex[2], Hex[2], Atot[2], Htot[2];
        const bf16x8 As = (eq == 0) ? Af[0] : (eq == 1) ? Af[1] : (eq == 2) ? Af[2] : Af[3];
#pragma unroll
        for (int nt = 0; nt < 2; ++nt) {
            f32x4 ga = {0.f, 0.f, 0.f, 0.f}, gx = {0.f, 0.f, 0.f, 0.f};
#pragma unroll
            for (int ks = 0; ks < 4; ++ks) { ga = MFMA16(Af[ks], wf[((0 * 2 + nt) * 4 + ks) * 64 + lane], ga); gx = MFMA16(Af[ks], wf[((1 * 2 + nt) * 4 + ks) * 64 + lane], gx); }
            const f32x4 xc = MFMA16(As, Id[nt], ((f32x4){0.f, 0.f, 0.f, 0.f}));
            float A = 1.f, H = 0.f;
#pragma unroll
            for (int r = 0; r < 4; ++r) {
                const float ra = sigm(ga[r] + ba[nt]), ix = sigm(gx[r] + bx[nt]);
                const float la = cl[nt] * ra, a = __expf(la), z = 2.0f * la;
                const float om = (z > -0.05f) ? -z * (1.0f + z * (0.5f + z * (0.16666667f + z * 0.041666668f))) : 1.0f - __expf(z);
                const float bt = sqrtf(om) * (ix * xc[r]);
                H = a * H + bt; A = a * A; Ap[nt][r] = A; Hp[nt][r] = H;
            }
            float A1 = __shfl_up(A, 16), H1 = __shfl_up(H, 16);
            if (lg >= 1) { H = A * H1 + H; A = A * A1; }
            A1 = __shfl_up(A, 32); H1 = __shfl_up(H, 32);
            if (lg >= 2) { H = A * H1 + H; A = A * A1; }
            float Ae = __shfl_up(A, 16), He = __shfl_up(H, 16);
            if (lg == 0) { Ae = 1.f; He = 0.f; }
            Aex[nt] = Ae; Hex[nt] = He;
            Atot[nt] = __shfl(A, 48 + l15); Htot[nt] = __shfl(H, 48 + l15);
            LRU_FENCE();
        }
        LAS float* xp = xch + (chunk & 1) * 512;
        if (lg == 0) {
#pragma unroll
            for (int nt = 0; nt < 2; ++nt) { xp[(wave * 32 + 16 * nt + l15) * 2] = Atot[nt]; xp[(wave * 32 + 16 * nt + l15) * 2 + 1] = Htot[nt]; }
        }
        __syncthreads();
#pragma unroll
        for (int nt = 0; nt < 2; ++nt) { float h = hprev[nt], hin = h;
#pragma unroll
            for (int w2 = 0; w2 < 8; ++w2) { if (w2 == wave) hin = h; const float Aw = xp[(w2 * 32 + 16 * nt + l15) * 2], Hw = xp[(w2 * 32 + 16 * nt + l15) * 2 + 1]; h = Aw * h + Hw; }
            hprev[nt] = h;
            const float hg = Aex[nt] * hin + Hex[nt];
#pragma unroll
            for (int r = 0; r < 4; ++r) { const float hv = Ap[nt][r] * hg + Hp[nt][r];
                *(bf16*)(obase + ((s0 + 4 * lgo + r) * 2048 + 32 * nt + 2 * l15o)) = (bf16)f2bf(hv * gelu_tanh(bf2f(yv[nt][r]))); } }
        LRU_FENCE();
#undef LRU_FENCE
    }
    __syncthreads();
}

DI void rope_norm_lane(float& v, const float* nw, const Ctx& C, int pos, int lane, bool do_norm) {
    if (do_norm) { const float ss = wave_sum(v * v); v = v * rsqrtf(ss * (1.0f / 64.0f) + 1e-6f) * nw[lane]; }
    const float other = __shfl_xor(v, 8);
    if (lane < 16) { const float c = C.ROPE_C()[pos * 8 + (lane & 7)], s = C.ROPE_S()[pos * 8 + (lane & 7)]; v = (lane < 8) ? v * c - other * s : v * c + other * s; }
}
DI void compress_item(const Ctx& C, int item, LAS unsigned char* lds) {
    const int lane = C.lane, wave = C.wave, l15 = lane & 15, lg = lane >> 4;
    const int kv = item >> 8, b = (item >> 5) & 7, g = (item >> 4) & 1, i0 = (item & 15) * 16;
    const bf16* W1T = kv ? C.PV1() : C.PK1(); const bf16* W2T = kv ? C.PV2() : C.PK2();
    LAS bf16* hid = (LAS bf16*)lds;
    LAS float* outs = (LAS float*)(lds + 16 * 264 * 2);
    const int irow = (i0 + l15 < 255) ? i0 + l15 : 254;
    const bf16* ap = C.KV() + (size_t)(b * SEQ + 16 * irow) * 768 + kv * 128 + g * 64 + 8 * lg;
    const bf16* bp0 = W1T + (size_t)(32 * wave + l15) * 2048 + 8 * lg; const bf16* bp1 = bp0 + 16 * 2048;
    f32x4 acc0 = {0.f, 0.f, 0.f, 0.f}, acc1 = {0.f, 0.f, 0.f, 0.f};
#pragma unroll 8
    for (int ks = 0; ks < 64; ++ks) {
        const bf16x8 a = *(const bf16x8*)(ap + (size_t)(ks >> 1) * 768 + (ks & 1) * 32);
        const bf16x8 b0 = *(const bf16x8*)(bp0 + ks * 32), b1 = *(const bf16x8*)(bp1 + ks * 32);
        acc0 = MFMA16(a, b0, acc0); acc1 = MFMA16(a, b1, acc1);
    }
    { const float bi0 = C.PHIB()[kv * 256 + 32 * wave + l15], bi1 = C.PHIB()[kv * 256 + 32 * wave + 16 + l15];
#pragma unroll
      for (int r = 0; r < 4; ++r) { hid[(4 * lg + r) * 264 + 32 * wave + l15] = (bf16)f2bf(gelu_tanh(acc0[r] + bi0)); hid[(4 * lg + r) * 264 + 32 * wave + 16 + l15] = (bf16)f2bf(gelu_tanh(acc1[r] + bi1)); } }
    __syncthreads();
    if (wave < 4) {
        f32x4 acc2 = {0.f, 0.f, 0.f, 0.f};
#pragma unroll
        for (int ks = 0; ks < 8; ++ks) { const bf16x8 a = *(const LAS bf16x8*)(hid + l15 * 264 + ks * 32 + 8 * lg); const bf16x8 bb = *(const bf16x8*)(W2T + (size_t)(16 * wave + l15) * 256 + ks * 32 + 8 * lg); acc2 = MFMA16(a, bb, acc2); }
#pragma unroll
        for (int r = 0; r < 4; ++r) outs[(4 * lg + r) * 64 + 16 * wave + l15] = acc2[r];
    }
    __syncthreads();
#pragma unroll
    for (int rr = 0; rr < 2; ++rr) { const int row = 2 * wave + rr, i = i0 + row;
        if (i < 255) { float v = outs[row * 64 + lane];
            if (kv == 0) rope_norm_lane(v, C.k_norm_w(), C, 16 * i + 31, lane, true);
            (kv ? C.VC() : C.KC())[(size_t)((b * 2 + g) * 256 + i) * 64 + lane] = (bf16)f2bf(v); } }
    __syncthreads();
}

DI void normrope8(v4u& w, const float* nw, const Ctx& C, int pos, int sub) {
    float v[8] = {__uint_as_float(w.x << 16), __uint_as_float(w.x & 0xffff0000u), __uint_as_float(w.y << 16), __uint_as_float(w.y & 0xffff0000u),
                  __uint_as_float(w.z << 16), __uint_as_float(w.z & 0xffff0000u), __uint_as_float(w.w << 16), __uint_as_float(w.w & 0xffff0000u)};
    float ss = 0.f;
#pragma unroll
    for (int j = 0; j < 8; ++j) ss += v[j] * v[j];
    ss += __shfl_xor(ss, 1); ss += __shfl_xor(ss, 2); ss += __shfl_xor(ss, 4);
    const float rstd = rsqrtf(ss * (1.0f / 64.0f) + 1e-6f);
#pragma unroll
    for (int j = 0; j < 8; ++j) v[j] = v[j] * rstd * nw[sub * 8 + j];
#pragma unroll
    for (int j = 0; j < 8; ++j) { const float other = __shfl_xor(v[j], 1);
        if (sub < 2) { const float c = C.ROPE_C()[pos * 8 + j], s = C.ROPE_S()[pos * 8 + j]; v[j] = (sub == 0) ? v[j] * c - other * s : v[j] * c + other * s; } }
    w.x = pk2(v[0], v[1]); w.y = pk2(v[2], v[3]); w.z = pk2(v[4], v[5]); w.w = pk2(v[6], v[7]);
}
DI void normrope_pair(const Ctx& C, int pair) {
    const int lane = C.lane, sub = lane & 7;
#pragma unroll
    for (int tk = 0; tk < 2; ++tk) { const int row = 2 * pair + tk; v4u* p = (v4u*)(C.Q() + (size_t)row * 512 + lane * 8); v4u w = *p; normrope8(w, C.q_norm_w(), C, row & (SEQ - 1), sub); *p = w; }
    { const int row = 2 * pair + (lane >> 5), vec = (lane >> 3) & 3;
      v4u* p = (v4u*)(C.KV() + (size_t)row * 768 + ((vec < 2) ? 256 : 512) + (vec & 1) * 64 + sub * 8); v4u w = *p;
      normrope8(w, C.k_norm_w() + ((vec < 2) ? 64 : 128), C, row & (SEQ - 1), sub); *p = w; }
}
DI void dot4(const bf16* kp, const LAS float* qs, float (&d)[4]) {
    d[0] = d[1] = d[2] = d[3] = 0.f;
#pragma unroll 1
    for (int c = 0; c < 8; ++c) {
        const v4u kw = *(const v4u*)(kp + 8 * c);
        const float k0 = __uint_as_float(kw.x << 16), k1 = __uint_as_float(kw.x & 0xffff0000u), k2 = __uint_as_float(kw.y << 16), k3 = __uint_as_float(kw.y & 0xffff0000u);
        const float k4 = __uint_as_float(kw.z << 16), k5 = __uint_as_float(kw.z & 0xffff0000u), k6 = __uint_as_float(kw.w << 16), k7 = __uint_as_float(kw.w & 0xffff0000u);
#pragma unroll
        for (int h = 0; h < 4; ++h) { const f32x4 qa = *(const LAS f32x4*)(qs + h * 64 + 8 * c), qb = *(const LAS f32x4*)(qs + h * 64 + 8 * c + 4);
            d[h] += (k0 * qa[0] + k1 * qa[1]) + (k2 * qa[2] + k3 * qa[3]) + (k4 * qb[0] + k5 * qb[1]) + (k6 * qb[2] + k7 * qb[3]); }
    }
}
DI void attend_blocks(const Ctx& C, int b, int t, unsigned long long mask, int kcol, int vcol, int lo, const LAS float* qs, LAS float* ps, float (&o)[4]) {
    const int lane = C.lane;
    float mloc[4] = {-1e30f, -1e30f, -1e30f, -1e30f};
    for (unsigned long long mm = mask; mm; mm &= mm - 1) {
        asm volatile("" ::: "memory");
        const int j = __builtin_ctzll(mm), tok = 64 * j + lane; const bool valid = tok >= lo && tok <= t;
        float d[4]; dot4(C.KV() + (size_t)(b * SEQ + tok) * 768 + kcol, qs, d);
#pragma unroll
        for (int h = 0; h < 4; ++h) if (valid) mloc[h] = fmaxf(mloc[h], d[h]);
    }
    float mx[4], lp[4] = {0.f, 0.f, 0.f, 0.f};
#pragma unroll
    for (int h = 0; h < 4; ++h) { mx[h] = wave_max(mloc[h]); o[h] = 0.f; }
    for (unsigned long long mm = mask; mm; mm &= mm - 1) {
        asm volatile("" ::: "memory");
        const int j = __builtin_ctzll(mm), tok = 64 * j + lane; const bool valid = tok >= lo && tok <= t;
        float d[4]; dot4(C.KV() + (size_t)(b * SEQ + tok) * 768 + kcol, qs, d);
#pragma unroll
        for (int h = 0; h < 4; ++h) { const float p = valid ? __expf(d[h] - mx[h]) : 0.f; lp[h] += p; ps[h * 64 + lane] = p; }
        LDS_WAIT(); asm volatile("" ::: "memory");
        const bf16* vp = C.KV() + (size_t)(b * SEQ + 64 * j) * 768 + vcol + lane;
#pragma unroll 4
        for (int kk = 0; kk < 64; ++kk) { const float v = bf2f(vp[(size_t)kk * 768]);
#pragma unroll
            for (int h = 0; h < 4; ++h) o[h] += ps[h * 64 + kk] * v; }
        LDS_WAIT(); asm volatile("" ::: "memory");
    }
#pragma unroll
    for (int h = 0; h < 4; ++h) o[h] /= wave_sum(lp[h]);
}
DI void attn_naive(const Ctx& C, int qidx, LAS float* wl) {
    const int lane = C.lane, b = qidx >> 13, g = (qidx >> 12) & 1, t = qidx & (SEQ - 1), row = b * SEQ + t;
    LAS float* qs = wl; LAS float* ps = wl + 256; LAS float* psum = wl + 256 + 1024;
#pragma unroll
    for (int h = 0; h < 4; ++h) qs[h * 64 + lane] = bf2f(C.Q()[(size_t)row * 512 + (g * 4 + h) * 64 + lane]) * 0.125f;
#pragma unroll
    for (int i = 0; i < 4; ++i) psum[i * 64 + lane] = 0.f;
    LDS_WAIT(); asm volatile("" ::: "memory");
    float gate[3][4], otot[4] = {0.f, 0.f, 0.f, 0.f};
#pragma unroll
    for (int br = 0; br < 3; ++br)
#pragma unroll
        for (int h = 0; h < 4; ++h) gate[br][h] = sigm(bf2f(C.GN()[(size_t)row * 32 + br * 8 + g * 4 + h]));
    const int nv = (t >= 31) ? ((t - 31) >> 4) + 1 : 0;
    if (nv > 0) {
        float sc[4][4];
#pragma unroll
        for (int rd = 0; rd < 4; ++rd) { asm volatile("" ::: "memory"); const int n = rd * 64 + lane; const bool valid = n < nv;
            float d[4]; dot4(C.KC() + (size_t)((b * 2 + g) * 256 + (valid ? n : 0)) * 64, qs, d);
#pragma unroll
            for (int h = 0; h < 4; ++h) sc[rd][h] = valid ? d[h] : -1e30f; }
        float pacc[4] = {0.f, 0.f, 0.f, 0.f};
#pragma unroll
        for (int h = 0; h < 4; ++h) {
            const float m = wave_max(fmaxf(fmaxf(sc[0][h], sc[1][h]), fmaxf(sc[2][h], sc[3][h])));
            float e[4], l = 0.f;
#pragma unroll
            for (int rd = 0; rd < 4; ++rd) { e[rd] = (rd * 64 + lane < nv) ? __expf(sc[rd][h] - m) : 0.f; l += e[rd]; }
            const float inv = 1.0f / wave_sum(l);
#pragma unroll
            for (int rd = 0; rd < 4; ++rd) { const float p = e[rd] * inv; ps[h * 256 + rd * 64 + lane] = p; pacc[rd] += p; }
        }
#pragma unroll
        for (int rd = 0; rd < 4; ++rd) psum[rd * 64 + lane] = pacc[rd];
        LDS_WAIT(); asm volatile("" ::: "memory");
        float oc[4] = {0.f, 0.f, 0.f, 0.f};
        const bf16* vp = C.VC() + (size_t)((b * 2 + g) * 256) * 64 + lane;
        for (int n = 0; n < nv; ++n) { const float v = bf2f(vp[n * 64]);
#pragma unroll
            for (int h = 0; h < 4; ++h) oc[h] += ps[h * 256 + n] * v; }
#pragma unroll
        for (int h = 0; h < 4; ++h) otot[h] += gate[0][h] * oc[h];
    }
    LDS_WAIT(); asm volatile("" ::: "memory");
    const int cur = t >> 6;
    float imp = 0.f;
#pragma unroll
    for (int k = -1; k <= 3; ++k) { const int n = 4 * lane + k; if (n >= 0 && n < 255) imp += psum[n]; }
    const float score = (lane > cur) ? -1e30f : ((lane == 0 || lane == cur || lane == cur - 1) ? 1e4f : imp);
    int cnt = 0;
#pragma unroll 4
    for (int jj = 0; jj < 64; ++jj) { const float sj = __shfl(score, jj); cnt += (sj > score || (sj == score && jj < lane)) ? 1 : 0; }
    unsigned long long sel = __ballot(cnt < 16);
    sel &= (cur == 63) ? ~0ull : ((1ull << (cur + 1)) - 1ull);
    LDS_WAIT(); asm volatile("" ::: "memory");
    float o[4];
    attend_blocks(C, b, t, sel, 256 + g * 64, 384 + g * 64, 0, qs, ps, o);
#pragma unroll
    for (int h = 0; h < 4; ++h) otot[h] += gate[1][h] * o[h];
    const int lo = (t >= 511) ? t - 511 : 0;
    unsigned long long wm = 0ull;
    for (int j = lo >> 6; j <= cur; ++j) wm |= 1ull << j;
    attend_blocks(C, b, t, wm, 512 + g * 64, 640 + g * 64, lo, qs, ps, o);
#pragma unroll
    for (int h = 0; h < 4; ++h) { otot[h] += gate[2][h] * o[h]; C.ONSA()[(size_t)row * 512 + (g * 4 + h) * 64 + lane] = (bf16)f2bf(otot[h]); }
}
#ifndef MK_N_LAUNCHES
#define MK_N_LAUNCHES 1
#endif
constexpr int N_PHASES = 8;
struct Args { const float* in[24]; float* out; unsigned char* ws; int ph_lo, ph_hi, use_bar, pad; };
__global__ void __launch_bounds__(NWAVES * 64, 2) mega_fwd(Args args) {
    extern __shared__ __attribute__((aligned(16))) unsigned char lds_raw[];
    LAS unsigned char* lds = (LAS unsigned char*)lds_raw;
    Ctx C;
    C.tid = threadIdx.x; C.lane = C.tid & 63; C.wave = __builtin_amdgcn_readfirstlane(C.tid >> 6);
    C.G = gridDim.x; { const int bx = blockIdx.x; C.vcu = (C.G % 8 == 0) ? (bx % 8) * (C.G / 8) + bx / 8 : bx; }
    unsigned char* ws = args.ws;
    C.in = args.in; C.outp = args.out; C.ws = ws;

    for (int u = C.tid; u < (LDS_BYTES - LDSCTL_OFF) / 4; u += NWAVES * 64) ((LAS unsigned*)(lds + LDSCTL_OFF))[u] = 0u;
    __syncthreads();
    gu32* ctl = (gu32*)(ws + WS_CTL);
    XcdBarrier bar; bar.bar = (unsigned*)(ctl + CW_BAR); bar.x = 0; bar.st = nullptr;
    if (args.use_bar) bar = xcd_barrier_post((unsigned*)(ctl + CW_BAR), (volatile LAS unsigned*)(lds + MISC_OFF) + 8);
    const int lo = args.ph_lo, hi = args.ph_hi;
#define IN(k) (lo <= (k) && (k) < hi)
#ifdef ONLY_PHASE
#define PHASE_ON(k) ((k) == ONLY_PHASE)
#else
#define PHASE_ON(k) true
#endif
#define SEAM(k) do { if (IN(k) && IN((k) + 1)) xcd_barrier(bar); } while (0)

    if (PHASE_ON(0) && IN(0)) { p0_prologue(C, lds); }
    SEAM(0);
    if (PHASE_ON(1) && IN(1)) {
        pg8::Gemm g{C.XN(), C.WIN(), T, NPROJ, DM}; pg8::StaticOrder S; S.init(T, NPROJ, C.G, (int)blockIdx.x);
        pg8::EpiProj E{C.ws};
        pg8::gemm_phase<pg8::EpiProj, pg8::StaticOrder, true, true>(lds + RING_OFF, g, S, E);
    }
    SEAM(1);
    if (PHASE_ON(2) && IN(2)) {
        for (int s = C.vcu; s < 256; s += C.G) lru_strip(C, s, lds);
        for (int it = C.vcu; it < 512; it += C.G) compress_item(C, it, lds);
        const int gw = C.vcu * NWAVES + C.wave, NGW = C.G * NWAVES;
        for (int p = gw; p < T / 2; p += NGW) normrope_pair(C, p);
    }
    SEAM(2);
    if (PHASE_ON(3) && IN(3)) {
        const int gw = C.vcu * NWAVES + C.wave, NGW = C.G * NWAVES;
        LAS float* wl = (LAS float*)(lds + C.wave * 8192);
        for (int q = gw; q < BATCH * 2 * SEQ; q += NGW) attn_naive(C, q, wl);
    }
    SEAM(3);
    if (PHASE_ON(4) && IN(4)) {
        { pg8::Gemm g{C.ONSA(), C.WNU(), T, DM, 512}; pg8::StaticOrder S; S.init(T, DM, C.G, (int)blockIdx.x);
          pg8::EpiMerge E{C.GM(), C.MERGED(), 0};
          pg8::gemm_phase<pg8::EpiMerge, pg8::StaticOrder, true, true>(lds + RING_OFF, g, S, E); }
        VM_WAIT(); __syncthreads();
        { pg8::Gemm g{C.OL(), C.WLU(), T, DM, DM}; pg8::StaticOrder S; S.init(T, DM, C.G, (int)blockIdx.x);
          pg8::EpiMerge E{C.GM(), C.MERGED(), 1};
          pg8::gemm_phase<pg8::EpiMerge, pg8::StaticOrder, true, true>(lds + RING_OFF, g, S, E); }
    }
    SEAM(4);
    if (PHASE_ON(5) && IN(5)) {
        pg8::Gemm g{C.MERGED(), C.WO(), T, DM, DM}; pg8::StaticOrder S; S.init(T, DM, C.G, (int)blockIdx.x);
        pg8::EpiWo E{C.x(), C.out(), C.HB(), C.SS()};
        pg8::gemm_phase<pg8::EpiWo, pg8::StaticOrder, true, true>(lds + RING_OFF, g, S, E);
    }
    SEAM(5);
    if (PHASE_ON(6) && IN(6)) {
        pg8::Gemm g{C.HB(), C.W1(), T, DFF, DM}; pg8::StaticOrder S; S.init(T, DFF, C.G, (int)blockIdx.x);
        pg8::EpiFF1 E{C.SS(), C.U()};
        pg8::gemm_phase<pg8::EpiFF1, pg8::StaticOrder, true, true>(lds + RING_OFF, g, S, E);
    }
    SEAM(6);
    if (PHASE_ON(7) && IN(7)) {
        pg8::Gemm g{C.U(), C.W2(), T, DM, DFF}; pg8::StaticOrder S; S.init(T, DM, C.G, (int)blockIdx.x);
        pg8::EpiFF2 E{C.out()};
        pg8::gemm_phase<pg8::EpiFF2, pg8::StaticOrder, true, true>(lds + RING_OFF, g, S, E);
    }
#undef IN
#undef SEAM
}

extern "C" void kernel_launch(void* const* d_in, const int* in_sizes, int n_in, void* d_out, int out_size, void* d_ws, size_t ws_size, hipStream_t stream) {
    static int grid = 0;
    if (grid == 0) {
        if (n_in != 24 || in_sizes[0] != T * DM || out_size != T * DM || ws_size < WS_END) { fprintf(stderr, "kernel_launch: unexpected shapes (n_in %d, in0 %d, out %d, ws %zu); nothing launched\n", n_in, n_in > 0 ? in_sizes[0] : -1, out_size, ws_size); grid = -1; return; }
        int dev = 0, cus = 0, per_cu = 0;
        if (hipGetDevice(&dev) != hipSuccess || hipDeviceGetAttribute(&cus, hipDeviceAttributeMultiprocessorCount, dev) != hipSuccess) { fprintf(stderr, "kernel_launch: device query failed\n"); grid = -1; return; }
        if (hipFuncSetAttribute((const void*)mega_fwd, hipFuncAttributeMaxDynamicSharedMemorySize, LDS_BYTES) != hipSuccess) { fprintf(stderr, "kernel_launch: hipFuncSetAttribute failed\n"); grid = -1; return; }
        if (hipOccupancyMaxActiveBlocksPerMultiprocessor(&per_cu, (const void*)mega_fwd, NWAVES * 64, LDS_BYTES) != hipSuccess || per_cu < 1) { fprintf(stderr, "kernel_launch: occupancy query says %d blocks per CU\n", per_cu); (void)hipGetLastError(); per_cu = 1; }
        grid = cus;
    }
    if (grid < 0) return;
    if (hipMemsetAsync((char*)d_ws + WS_CTL, 0, CTL_ZERO_BYTES, stream) != hipSuccess) { fprintf(stderr, "kernel_launch: memset failed\n"); return; }
    Args a{};
    for (int i = 0; i < 24; ++i) a.in[i] = (const float*)d_in[i];
    a.out = (float*)d_out; a.ws = (unsigned char*)d_ws;
#if MK_N_LAUNCHES == 1
    a.ph_lo = 0; a.ph_hi = N_PHASES; a.use_bar = 1;
    void* params[] = {&a};
    hipError_t e = hipLaunchCooperativeKernel((const void*)mega_fwd, dim3(grid), dim3(NWAVES * 64), params, LDS_BYTES, stream);
    if (e != hipSuccess) fprintf(stderr, "kernel_launch: cooperative launch failed: %s (grid %d)\n", hipGetErrorString(e), grid);
#else
    for (int p = 0; p < N_PHASES; ++p) {
        a.ph_lo = p; a.ph_hi = p + 1; a.use_bar = 0;
        hipLaunchKernelGGL(mega_fwd, dim3(grid), dim3(NWAVES * 64), LDS_BYTES, stream, a);
    }
#endif
}
```

```cpp
#include <hip/hip_runtime.h>
#include <cstdio>
#include <cstdint>
#define MK_N_LAUNCHES 1
#define DI __device__ __forceinline__
constexpr int NWAVES = 8;
constexpr int BATCH = 8, SEQ = 4096, DM = 1024, T = BATCH * SEQ;
constexpr int NPROJ = 5632, DFF = 4096;
constexpr size_t MiB = 1u << 20;
constexpr size_t WS_CTL = 0, CTL_ZERO_BYTES = 64 * 1024;
constexpr size_t WS_SS = 256 * 1024;
constexpr size_t WS_TAB = 1 * MiB;
constexpr size_t WS_WIN = 2 * MiB, WS_WM = 13 * MiB  , WS_WO = 16 * MiB, WS_W1 = 18 * MiB, WS_W2 = 26 * MiB;
constexpr size_t WS_PK1 = 34 * MiB, WS_PV1 = 35 * MiB, WS_PK2 = 36 * MiB, WS_PV2 = 36 * MiB + 64 * 1024, WS_LWA = 36 * MiB + 128 * 1024, WS_LWX = 36 * MiB + 384 * 1024;
constexpr size_t WS_KC = 37 * MiB, WS_VC = 37 * MiB + 512 * 1024, WS_GN = 472 * MiB;
constexpr size_t WS_XN = 40 * MiB, WS_COMB = 40 * MiB  , WS_Q = 136 * MiB, WS_KV = 168 * MiB, WS_XR = 216 * MiB, WS_YR = 280 * MiB, WS_GM = 344 * MiB, WS_END = 474 * MiB;
constexpr size_t WS_HB = WS_XN, WS_MERGED = WS_XR, WS_U = WS_Q;
constexpr int CW_TMO = 0, CW_CODE = 1, CW_BAR = 4096;
constexpr int RING_OFF = 0, RING_BYTES = 131072;
constexpr int LDSCTL_OFF = RING_BYTES, MISC_OFF = LDSCTL_OFF + 320;
constexpr int XMB_OFF = RING_BYTES + 1024, XMB_BYTES = 3 * 8192;
constexpr int LDS_BYTES = 147456;
namespace pg8 {
#define PG8_LAS __attribute__((address_space(3)))
typedef unsigned short bf16_t;
typedef short bf16x8 __attribute__((ext_vector_type(8)));
typedef float f32x4 __attribute__((ext_vector_type(4)));
typedef unsigned u32x4 __attribute__((ext_vector_type(4)));
constexpr int BM = 256, BK = 64, HALF = 128, HTB = HALF * BK * 2  , STAGE_BYTES = 8 * HTB, NXCD = 8, WGM = 8;

__host__ __device__ __forceinline__ int lds_byte(int r, int c) { const int st = (r >> 4) * 2 + (c >> 5), rr = r & 15, cc = c & 31, ob = rr * 64 + cc * 2; return st * 1024 + (ob ^ (((ob >> 9) & 1) << 5)); }
__host__ __device__ __forceinline__ void stage_rc(int b, int& R, int& C) { const int st = b / 1024, sb = b % 1024, swz = sb ^ (((sb >> 9) & 1) << 5); R = (st >> 1) * 16 + swz / 64; C = (st & 1) * 32 + (swz % 64) / 2; }
__host__ __device__ __forceinline__ int perm32(int rho) { const int n = rho >> 4, i = rho & 15; return 8 * (i >> 2) + 4 * n + (i & 3); }

struct Unit { int pm, pn; };
struct Gemm { const bf16_t* A; const bf16_t* Bt; int M, N, K; };

struct StaticOrder {
    int nM, nN, nwg, G, c, rev, wgm;
    __host__ __device__ void init(int M, int N, int G_, int c_, int rev_ = 0, int wgm_ = WGM) { nM = M / BM; nN = N / BM; nwg = nM * nN; G = G_; c = c_; rev = rev_; wgm = wgm_; }
    __host__ __device__ bool next(int i, Unit& u) const {
        const long L = (long)i * G + c; if (L >= nwg) return false;
        int wgid = (int)L; { const int q = nwg / NXCD, r = nwg % NXCD, xcd = wgid % NXCD, off = wgid / NXCD; wgid = (xcd < r ? xcd * (q + 1) : r * (q + 1) + (xcd - r) * q) + off; }
        const int nig = wgm * nN, gid = wgid / nig, fm = gid * wgm, gsz = (nM - fm) < wgm ? (nM - fm) : wgm;
        u.pm = fm + ((wgid % nig) % gsz); u.pn = (wgid % nig) / gsz; if (rev) u.pm = nM - 1 - u.pm; return true;
    }
    __device__ __forceinline__ void a_ready(const Unit&) const {}
    __device__ __forceinline__ void done(const Unit&) const {}
};

__device__ __forceinline__ unsigned cvt_pk_bf16(float lo, float hi) { unsigned r; asm volatile("v_cvt_pk_bf16_f32 %0, %1, %2" : "=v"(r) : "v"(lo), "v"(hi)); return r; }
typedef float f32x2 __attribute__((ext_vector_type(2)));
typedef unsigned u32x2 __attribute__((ext_vector_type(2)));
__device__ __forceinline__ float bf_lo(unsigned w) { return __uint_as_float(w << 16); }
__device__ __forceinline__ float bf_hi(unsigned w) { return __uint_as_float(w & 0xffff0000u); }
__device__ __forceinline__ float sigm(float x) { return __builtin_amdgcn_rcpf(1.0f + __expf(-x)); }
__device__ __forceinline__ u32x4 pack8(const f32x4 v0, const f32x4 v1) { u32x4 w; w.x = cvt_pk_bf16(v0[0], v0[1]); w.y = cvt_pk_bf16(v0[2], v0[3]); w.z = cvt_pk_bf16(v1[0], v1[1]); w.w = cvt_pk_bf16(v1[2], v1[3]); return w; }

struct EpiProj {
    static constexpr bool PERM = true, AFTER_DRAIN = false, ATILED = true;     static constexpr int HOOK_T = 0;
    unsigned char* ws;
    __device__ __forceinline__ void operator()(const f32x4 (&acc)[2][2][4][2], const Unit& u, int wr, int wc, int fr, int fq) const {
        const int pn = u.pn; size_t boff; int ldc, colt;
        if (pn < 2) { boff = ::WS_Q; ldc = 512; colt = pn * 256; }
        else if (pn < 5) { boff = ::WS_KV; ldc = 768; colt = (pn - 2) * 256; }
        else if (pn < 9) { boff = ::WS_XR; ldc = 1024; colt = (pn - 5) * 256; }
        else if (pn < 13) { boff = ::WS_YR; ldc = 1024; colt = (pn - 9) * 256; }
        else if (pn < 21) { boff = ::WS_GM; ldc = 2048; colt = (pn - 13) * 256; }
        else { boff = ::WS_GN; ldc = 32; colt = 0; }
        bf16_t* base = (bf16_t*)(ws + boff);
        const int row0 = u.pm * BM + wr * 64 + fr, col0 = colt + wc * 32 + 8 * fq;
        const bool narrow = (pn == 21);
        if (narrow && wc != 0) return;
#pragma unroll
        for (int ai = 0; ai < 2; ++ai)
#pragma unroll
            for (int m = 0; m < 4; ++m) { bf16_t* rowp = base + (size_t)(row0 + ai * HALF + m * 16) * ldc + col0;
#pragma unroll
                for (int bj = 0; bj < 2; ++bj) { if (narrow && bj) continue; *(u32x4*)(rowp + bj * HALF) = pack8(acc[ai][bj][m][0], acc[ai][bj][m][1]); } }
    }
};
__device__ __forceinline__ float expc(float x) { return __expf(fminf(fmaxf(x, -30.f), 30.f)); }
struct EpiMerge {
    static constexpr bool PERM = true, AFTER_DRAIN = false, ATILED = true;     static constexpr int HOOK_T = 8;
    const bf16_t* GM; bf16_t* O;
    __device__ __forceinline__ void hook(f32x4 (&acc)[2][2][4][2], const Unit& u, int wr, int wc, int fr, int fq) const {
        const bf16_t* p = GM + (size_t)(u.pm * BM + wr * 64 + fr) * 2048 + u.pn * BM + wc * 32 + 8 * fq;
#pragma unroll
        for (int ai = 0; ai < 2; ++ai)
#pragma unroll
            for (int mh = 0; mh < 2; ++mh) {
                asm volatile("" : "+v"(p));
                u32x4 ga[2][2], gb[2][2];
#pragma unroll
                for (int mm = 0; mm < 2; ++mm)
#pragma unroll
                    for (int bj = 0; bj < 2; ++bj) { ga[mm][bj] = *(const u32x4*)(p + mm * 16 * 2048 + bj * HALF); gb[mm][bj] = *(const u32x4*)(p + mm * 16 * 2048 + 1024 + bj * HALF); }
#pragma unroll
                for (int mm = 0; mm < 2; ++mm)
#pragma unroll
                    for (int bj = 0; bj < 2; ++bj) { const int m = 2 * mh + mm; const u32x4 a = ga[mm][bj], b = gb[mm][bj];
#define PG8_RATIO(a_, b_) ((1.0f + expc(-(b_))) * __builtin_amdgcn_rcpf(1.0f + expc(-(a_))))
                        acc[ai][bj][m][0][0] *= PG8_RATIO(bf_lo(a.x), bf_lo(b.x)); acc[ai][bj][m][0][1] *= PG8_RATIO(bf_hi(a.x), bf_hi(b.x));
                        acc[ai][bj][m][0][2] *= PG8_RATIO(bf_lo(a.y), bf_lo(b.y)); acc[ai][bj][m][0][3] *= PG8_RATIO(bf_hi(a.y), bf_hi(b.y));
                        acc[ai][bj][m][1][0] *= PG8_RATIO(bf_lo(a.z), bf_lo(b.z)); acc[ai][bj][m][1][1] *= PG8_RATIO(bf_hi(a.z), bf_hi(b.z));
                        acc[ai][bj][m][1][2] *= PG8_RATIO(bf_lo(a.w), bf_lo(b.w)); acc[ai][bj][m][1][3] *= PG8_RATIO(bf_hi(a.w), bf_hi(b.w));
#undef PG8_RATIO
                        asm volatile("" : "+v"(acc[ai][bj][m][0]), "+v"(acc[ai][bj][m][1])); }
                asm volatile("" ::: "memory");
                p += (mh == 1 ? (HALF - 32) : 32) * 2048;
            }
    }
    __device__ __forceinline__ void operator()(const f32x4 (&acc)[2][2][4][2], const Unit& u, int wr, int wc, int fr, int fq) const {
        const int row0 = u.pm * BM + wr * 64 + fr, col0 = u.pn * BM + wc * 32 + 8 * fq;
        u32x4 gv[2][4][2];
#pragma unroll
        for (int ai = 0; ai < 2; ++ai)
#pragma unroll
            for (int m = 0; m < 4; ++m)
#pragma unroll
                for (int bj = 0; bj < 2; ++bj) gv[ai][m][bj] = *(const u32x4*)(GM + (size_t)(row0 + ai * HALF + m * 16) * 2048 + 1024 + col0 + bj * HALF);
#pragma unroll
        for (int ai = 0; ai < 2; ++ai)
#pragma unroll
            for (int m = 0; m < 4; ++m) asm volatile("" : "+v"(gv[ai][m][0]), "+v"(gv[ai][m][1]));
#pragma unroll
        for (int ai = 0; ai < 2; ++ai)
#pragma unroll
            for (int m = 0; m < 4; ++m) { const size_t row = (size_t)(row0 + ai * HALF + m * 16);
#pragma unroll
                for (int bj = 0; bj < 2; ++bj) { const int col = col0 + bj * HALF; const u32x4 g = gv[ai][m][bj];
                    f32x4 v0 = acc[ai][bj][m][0], v1 = acc[ai][bj][m][1];
#define PG8_SIG(b_) __builtin_amdgcn_rcpf(1.0f + expc(-(b_)))
                    v0[0] *= PG8_SIG(bf_lo(g.x)); v0[1] *= PG8_SIG(bf_hi(g.x)); v0[2] *= PG8_SIG(bf_lo(g.y)); v0[3] *= PG8_SIG(bf_hi(g.y));
                    v1[0] *= PG8_SIG(bf_lo(g.z)); v1[1] *= PG8_SIG(bf_hi(g.z)); v1[2] *= PG8_SIG(bf_lo(g.w)); v1[3] *= PG8_SIG(bf_hi(g.w));
#undef PG8_SIG
                    *(u32x4*)(O + (size_t)u.pm * (BM * 1024) + (size_t)(u.pn * 4 + bj * 2 + (wc >> 1)) * (BM * 64) + ((int)row & 255) * 64 + (wc & 1) * 32 + 8 * fq) = pack8(v0, v1); (void)col; } }
    }
};
struct EpiWo {
    static constexpr bool PERM = false, AFTER_DRAIN = false, ATILED = true;     static constexpr int HOOK_T = 0;
    const float* X; bf16_t* HB; float* SS;
    __device__ __forceinline__ void operator()(const f32x4 (&acc)[2][2][4][2], const Unit& u, int wr, int wc, int fr, int fq) const {
        const int row0 = u.pm * BM + wr * 64 + fr, col0 = u.pn * BM + wc * 32 + 4 * fq;
#pragma unroll
        for (int ai = 0; ai < 2; ++ai) {
            f32x4 xv[4][2][2];
#pragma unroll
            for (int m = 0; m < 4; ++m)
#pragma unroll
                for (int bj = 0; bj < 2; ++bj)
#pragma unroll
                    for (int n = 0; n < 2; ++n) xv[m][bj][n] = *(const f32x4*)(X + (size_t)(row0 + ai * HALF + m * 16) * 1024 + col0 + bj * HALF + n * 16);
#pragma unroll
            for (int m = 0; m < 4; ++m) asm volatile("" : "+v"(xv[m][0][0]), "+v"(xv[m][0][1]), "+v"(xv[m][1][0]), "+v"(xv[m][1][1]));
#pragma unroll
            for (int m = 0; m < 4; ++m) { const int row = row0 + ai * HALF + m * 16; float ss = 0.f;
#pragma unroll
                for (int bj = 0; bj < 2; ++bj)
#pragma unroll
                    for (int n = 0; n < 2; ++n) { const size_t off = (size_t)row * 1024 + col0 + bj * HALF + n * 16;
                        const f32x4 h = xv[m][bj][n] + acc[ai][bj][m][n];
                        ss += (h[0] * h[0] + h[1] * h[1]) + (h[2] * h[2] + h[3] * h[3]);
                        u32x2 w; w.x = cvt_pk_bf16(h[0], h[1]); w.y = cvt_pk_bf16(h[2], h[3]); *(u32x2*)(HB + (size_t)u.pm * (BM * 1024) + (size_t)(u.pn * 4 + bj * 2 + (wc >> 1)) * (BM * 64) + (row & 255) * 64 + (wc & 1) * 32 + 4 * fq + 16 * n) = w; (void)off; }
                ss += __shfl_xor(ss, 16); ss += __shfl_xor(ss, 32);
                if (fq == 0) atomicAdd(SS + row, ss); }
        }
    }
};
struct EpiFF1 {
    static constexpr bool PERM = true, AFTER_DRAIN = false, ATILED = true;     static constexpr int HOOK_T = 0;
    const float* SS; bf16_t* U;
    __device__ __forceinline__ void operator()(const f32x4 (&acc)[2][2][4][2], const Unit& u, int wr, int wc, int fr, int fq) const {
        const int row0 = u.pm * BM + wr * 64 + fr, col0 = u.pn * BM + wc * 32 + 8 * fq;
        float ssv[2][4];
#pragma unroll
        for (int ai = 0; ai < 2; ++ai)
#pragma unroll
            for (int m = 0; m < 4; ++m) ssv[ai][m] = SS[row0 + ai * HALF + m * 16];
        asm volatile("" : "+v"(ssv[0][0]), "+v"(ssv[0][1]), "+v"(ssv[0][2]), "+v"(ssv[0][3]), "+v"(ssv[1][0]), "+v"(ssv[1][1]), "+v"(ssv[1][2]), "+v"(ssv[1][3]));
#pragma unroll
        for (int ai = 0; ai < 2; ++ai)
#pragma unroll
            for (int m = 0; m < 4; ++m) { const int row = row0 + ai * HALF + m * 16; const float sc = rsqrtf(ssv[ai][m] * (1.0f / 1024.0f) + 1e-6f);
#pragma unroll
                for (int bj = 0; bj < 2; ++bj) { f32x4 v0 = acc[ai][bj][m][0] * sc, v1 = acc[ai][bj][m][1] * sc;
#pragma unroll
                    for (int i = 0; i < 4; ++i) { const float a = fmaxf(v0[i], 0.f), b = fmaxf(v1[i], 0.f); v0[i] = a * a; v1[i] = b * b; }
                    *(u32x4*)(U + (size_t)u.pm * (BM * 4096) + (size_t)(u.pn * 4 + bj * 2 + (wc >> 1)) * (BM * 64) + (row & 255) * 64 + (wc & 1) * 32 + 8 * fq) = pack8(v0, v1); } }
    }
};
struct EpiFF2 {
    static constexpr bool PERM = false, AFTER_DRAIN = false, ATILED = true;     static constexpr int HOOK_T = 0;
    const bf16_t* HB; float* OUT;
    __device__ __forceinline__ void operator()(const f32x4 (&acc)[2][2][4][2], const Unit& u, int wr, int wc, int fr, int fq) const {
        const int row0 = u.pm * BM + wr * 64 + fr, col0 = u.pn * BM + wc * 32 + 4 * fq;
        u32x2 hv[2][4][2][2];
#pragma unroll
        for (int ai = 0; ai < 2; ++ai)
#pragma unroll
            for (int m = 0; m < 4; ++m)
#pragma unroll
                for (int bj = 0; bj < 2; ++bj)
#pragma unroll
                    for (int n = 0; n < 2; ++n) hv[ai][m][bj][n] = *(const u32x2*)(HB + (size_t)u.pm * (BM * 1024) + (size_t)(u.pn * 4 + bj * 2 + (wc >> 1)) * (BM * 64) + ((row0 + ai * HALF + m * 16) & 255) * 64 + (wc & 1) * 32 + 4 * fq + 16 * n);
#pragma unroll
        for (int ai = 0; ai < 2; ++ai)
#pragma unroll
            for (int m = 0; m < 4; ++m) asm volatile("" : "+v"(hv[ai][m][0][0]), "+v"(hv[ai][m][0][1]), "+v"(hv[ai][m][1][0]), "+v"(hv[ai][m][1][1]));
#pragma unroll
        for (int ai = 0; ai < 2; ++ai)
#pragma unroll
            for (int m = 0; m < 4; ++m)
#pragma unroll
                for (int bj = 0; bj < 2; ++bj)
#pragma unroll
                    for (int n = 0; n < 2; ++n) { const u32x2 w = hv[ai][m][bj][n]; f32x4 h; h[0] = bf_lo(w.x); h[1] = bf_hi(w.x); h[2] = bf_lo(w.y); h[3] = bf_hi(w.y);
                        *(f32x4*)(OUT + (size_t)(row0 + ai * HALF + m * 16) * 1024 + col0 + bj * HALF + n * 16) = h + acc[ai][bj][m][n]; }
    }
};
template <class Epi, class Sched, bool ALIGN_EPI = false, bool SP2 = false>
__device__ __forceinline__ void gemm_phase(PG8_LAS unsigned char* lds, const Gemm g, const Sched& S, const Epi& E) {
    const int tid = threadIdx.x, wid = __builtin_amdgcn_readfirstlane(tid >> 6), lane = tid & 63, wr = wid >> 2, wc = wid & 3, fr = lane & 15, fq = lane >> 4;
    const int K = g.K, nt = K / BK;
    constexpr bool AT = Epi::ATILED;
    unsigned voffA[2], voffB[2];
#pragma unroll
    for (int i = 0; i < 2; ++i) { int R, C; stage_rc(tid * 16 + i * 8192, R, C); const int Rb = Epi::PERM ? ((R & ~31) + perm32(R & 31)) : R;
        voffA[i] = (unsigned)(R * (AT ? BK : K) + C) * 2u; voffB[i] = (unsigned)(Rb * K + C) * 2u; }
    const size_t istepB = (size_t)64 * K * 2, istepA = AT ? (size_t)64 * BK * 2 : istepB;
    const size_t kstepB = (size_t)(BK * 2), kstepA = AT ? (size_t)BM * BK * 2 : kstepB;
    const size_t hstepB = (size_t)HALF * K * 2, hstepA = AT ? (size_t)HALF * BK * 2 : hstepB;
    const size_t tstep = (size_t)BM * K * 2;
    const unsigned ldsw = (unsigned)wid * 1024u;
    const int aoff = lds_byte(wr * 64 + fr, fq * 8), boff = lds_byte(wc * 32 + fr, fq * 8);
#define PG8_SA(b, h) (((b) * 2 + (h)) * HTB)
#define PG8_SB(b, h) ((4 + (b) * 2 + (h)) * HTB)
#define PG8_STAGE_(bufoff, gbase, voff, istep_) do { _Pragma("unroll") for (int _i = 0; _i < 2; ++_i) \
        __builtin_amdgcn_global_load_lds((const unsigned*)((const char*)(gbase) + (size_t)_i * (istep_) + (voff)[0]), (PG8_LAS unsigned*)(lds + (bufoff) + ldsw + _i * 8192), 16, 0, 0); } while (0)
#define PG8_STAGEA(bufoff, gbase) PG8_STAGE_(bufoff, gbase, voffA, istepA)
#define PG8_STAGEB(bufoff, gbase) PG8_STAGE_(bufoff, gbase, voffB, istepB)
#define PG8_LDA(dst, b, h) do { _Pragma("unroll") for (int m = 0; m < 4; ++m) _Pragma("unroll") for (int k = 0; k < 2; ++k) dst[m][k] = *(const PG8_LAS bf16x8*)(lds + PG8_SA(b, h) + aoff + m * 2048 + k * 1024); } while (0)
#define PG8_LDB(dst, b, h) do { _Pragma("unroll") for (int n = 0; n < 2; ++n) _Pragma("unroll") for (int k = 0; k < 2; ++k) dst[n][k] = *(const PG8_LAS bf16x8*)(lds + PG8_SB(b, h) + boff + n * 2048 + k * 1024); } while (0)
#define PG8_MMA(ai, bj, At, Bt) do { __builtin_amdgcn_s_setprio(1); _Pragma("unroll") for (int m = 0; m < 4; ++m) _Pragma("unroll") for (int n = 0; n < 2; ++n) _Pragma("unroll") for (int k = 0; k < 2; ++k) \
        acc[ai][bj][m][n] = __builtin_amdgcn_mfma_f32_16x16x32_bf16(Bt[n][k], At[m][k], acc[ai][bj][m][n], 0, 0, 0); __builtin_amdgcn_s_setprio(0); } while (0)
#define PG8_WAIT_V(n) asm volatile("s_waitcnt vmcnt(" #n ")" ::: "memory")
#define PG8_WAIT_L(n) asm volatile("s_waitcnt lgkmcnt(" #n ")" ::: "memory")
#define PG8_BAR __builtin_amdgcn_s_barrier()
#define PG8_SCHED __builtin_amdgcn_sched_barrier(0)
    Unit cur, nxt; int ui = 0;
    if (!S.next(0, cur)) return;
    f32x4 acc[2][2][4][2];
#pragma unroll
    for (int a = 0; a < 2; ++a)
#pragma unroll
        for (int b = 0; b < 2; ++b)
#pragma unroll
            for (int m = 0; m < 4; ++m)
#pragma unroll
                for (int n = 0; n < 2; ++n) acc[a][b][m][n] = (f32x4){0.f, 0.f, 0.f, 0.f};
    bf16x8 At[4][2], B0[2][2], B1[2][2];
    const char* cA = (const char*)g.A + (size_t)cur.pm * tstep; const char* cB = (const char*)g.Bt + (size_t)cur.pn * tstep;
    S.a_ready(cur);
    if constexpr (SP2) {
        PG8_STAGEB(PG8_SB(0, 0), cB); PG8_STAGEB(PG8_SB(0, 1), cB + hstepB); PG8_STAGEA(PG8_SA(0, 0), cA); PG8_STAGEA(PG8_SA(0, 1), cA + hstepA);
        if (wr == 1) PG8_BAR;
        PG8_WAIT_V(2); PG8_BAR;
        PG8_STAGEB(PG8_SB(1, 0), cB + kstepB); PG8_STAGEA(PG8_SA(1, 0), cA + kstepA); PG8_STAGEB(PG8_SB(1, 1), cB + hstepB + kstepB);
        PG8_WAIT_V(6); PG8_BAR;
    } else {
        PG8_STAGEB(PG8_SB(0, 0), cB); PG8_STAGEA(PG8_SA(0, 0), cA); PG8_STAGEB(PG8_SB(0, 1), cB + hstepB); PG8_STAGEA(PG8_SA(0, 1), cA + hstepA);
        if (wr == 1) PG8_BAR;
        PG8_WAIT_V(4); PG8_BAR;
        PG8_STAGEB(PG8_SB(1, 0), cB + kstepB); PG8_STAGEA(PG8_SA(1, 0), cA + kstepA); PG8_STAGEB(PG8_SB(1, 1), cB + hstepB + kstepB);
        PG8_WAIT_V(6); PG8_BAR;
    }
    for (;;) {
        const bool has_next = S.next(ui + 1, nxt);
        const char* nA = has_next ? (const char*)g.A + (size_t)nxt.pm * tstep : cA; const char* nB = has_next ? (const char*)g.Bt + (size_t)nxt.pn * tstep : cB;
        for (int t = 0; t < nt; t += 2) {
            const bool last = (t == nt - 2);
            const char* a1 = cA + (size_t)(t + 1) * kstepA;
            const char* a2 = last ? nA : cA + (size_t)(t + 2) * kstepA; const char* b2 = last ? nB : cB + (size_t)(t + 2) * kstepB;
            const char* a3 = a2 + kstepA; const char* b3 = b2 + kstepB;
            if (last && has_next) S.a_ready(nxt);
            if constexpr (Epi::HOOK_T > 0) { if (t == Epi::HOOK_T) E.hook(acc, cur, wr, wc, fr, fq); }
            if constexpr (SP2) {
            PG8_LDB(B0, 0, 0); PG8_LDB(B1, 0, 1); PG8_SCHED; PG8_LDA(At, 0, 0); PG8_STAGEA(PG8_SA(1, 1), a1 + hstepA);
            PG8_WAIT_V(8); PG8_WAIT_L(0); PG8_BAR; PG8_MMA(0, 0, At, B0); PG8_MMA(0, 1, At, B1); PG8_BAR; PG8_SCHED;
            PG8_LDA(At, 0, 1); PG8_STAGEB(PG8_SB(0, 0), b2); PG8_STAGEB(PG8_SB(0, 1), b2 + hstepB); PG8_STAGEA(PG8_SA(0, 0), a2);
            PG8_WAIT_V(8); PG8_WAIT_L(0); PG8_BAR; PG8_MMA(1, 0, At, B0); PG8_MMA(1, 1, At, B1); PG8_BAR; PG8_SCHED;
            PG8_LDB(B0, 1, 0); PG8_LDB(B1, 1, 1); PG8_SCHED; PG8_LDA(At, 1, 0); PG8_STAGEA(PG8_SA(0, 1), a2 + hstepA);
            PG8_WAIT_V(8); PG8_WAIT_L(0); PG8_BAR; PG8_MMA(0, 0, At, B0); PG8_MMA(0, 1, At, B1); PG8_BAR; PG8_SCHED;
            PG8_LDA(At, 1, 1); PG8_STAGEB(PG8_SB(1, 0), b3); PG8_STAGEB(PG8_SB(1, 1), b3 + hstepB); PG8_STAGEA(PG8_SA(1, 0), a3);
            PG8_WAIT_V(8); PG8_WAIT_L(0); PG8_BAR; PG8_MMA(1, 0, At, B0); PG8_MMA(1, 1, At, B1); PG8_BAR; PG8_SCHED;
            } else {
            PG8_LDB(B0, 0, 0); PG8_SCHED; PG8_LDA(At, 0, 0); PG8_STAGEA(PG8_SA(1, 1), a1 + hstepA);
            PG8_WAIT_L(8); PG8_BAR; PG8_WAIT_L(0); PG8_MMA(0, 0, At, B0); PG8_BAR; PG8_SCHED;
            PG8_LDB(B1, 0, 1); PG8_STAGEB(PG8_SB(0, 0), b2);
            PG8_BAR; PG8_WAIT_L(0); PG8_MMA(0, 1, At, B1); PG8_BAR;
            PG8_LDA(At, 0, 1); PG8_STAGEA(PG8_SA(0, 0), a2);
            PG8_BAR; PG8_WAIT_L(0); PG8_MMA(1, 0, At, B0); PG8_BAR; PG8_SCHED;
            PG8_STAGEB(PG8_SB(0, 1), b2 + hstepB);
            PG8_WAIT_V(6); PG8_BAR; PG8_MMA(1, 1, At, B1); PG8_BAR;
            PG8_LDB(B0, 1, 0); PG8_SCHED; PG8_LDA(At, 1, 0); PG8_STAGEA(PG8_SA(0, 1), a2 + hstepA);
            PG8_WAIT_L(8); PG8_BAR; PG8_WAIT_L(0); PG8_MMA(0, 0, At, B0); PG8_BAR; PG8_SCHED;
            PG8_LDB(B1, 1, 1); PG8_STAGEB(PG8_SB(1, 0), b3);
            PG8_BAR; PG8_WAIT_L(0); PG8_MMA(0, 1, At, B1); PG8_BAR;
            PG8_LDA(At, 1, 1); PG8_STAGEA(PG8_SA(1, 0), a3);
            PG8_BAR; PG8_WAIT_L(0); PG8_MMA(1, 0, At, B0); PG8_BAR; PG8_SCHED;
            PG8_STAGEB(PG8_SB(1, 1), b3 + hstepB);
            PG8_WAIT_V(6); PG8_BAR; PG8_MMA(1, 1, At, B1); PG8_BAR;
            }
        }
        if constexpr (ALIGN_EPI) { if (wr == 0) PG8_BAR; }
        if constexpr (!Epi::AFTER_DRAIN) { E(acc, cur, wr, wc, fr, fq); S.done(cur); }
        if (!has_next) break;
#pragma unroll
        for (int a = 0; a < 2; ++a)
#pragma unroll
            for (int b = 0; b < 2; ++b)
#pragma unroll
                for (int m = 0; m < 4; ++m)
#pragma unroll
                    for (int n = 0; n < 2; ++n) acc[a][b][m][n] = (f32x4){0.f, 0.f, 0.f, 0.f};
        cur = nxt; cA = nA; cB = nB; ++ui;
        if constexpr (ALIGN_EPI) { if (wr == 1) PG8_BAR; }
    }
    PG8_WAIT_V(0);
    if constexpr (!ALIGN_EPI) { if (wr == 0) PG8_BAR; }
    PG8_BAR;
    if constexpr (Epi::AFTER_DRAIN) { E.fused(acc, cur, wr, wc, fr, fq, lds, wid, lane); S.done(cur); }
#undef PG8_SA
#undef PG8_SB
#undef PG8_STAGE_
#undef PG8_STAGEA
#undef PG8_STAGEB
#undef PG8_LDA
#undef PG8_LDB
#undef PG8_MMA
#undef PG8_WAIT_V
#undef PG8_WAIT_L
#undef PG8_BAR
#undef PG8_SCHED
}
}
#define GAS __attribute__((address_space(1)))
#define LAS __attribute__((address_space(3)))
typedef unsigned short bf16;
typedef unsigned v4u __attribute__((ext_vector_type(4)));
typedef float f32x4 __attribute__((ext_vector_type(4)));
typedef short bf16x8 __attribute__((ext_vector_type(8)));
typedef GAS unsigned gu32;
typedef GAS unsigned long long gu64;
#define RLX_AGENT __ATOMIC_RELAXED, __HIP_MEMORY_SCOPE_AGENT
#define LDS_WAIT() asm volatile("s_waitcnt lgkmcnt(0)" ::: "memory")
#define VM_WAIT() asm volatile("s_waitcnt vmcnt(0)" ::: "memory")
__device__ __forceinline__ unsigned long long rt() { return __builtin_amdgcn_s_memrealtime(); }
__device__ __forceinline__ unsigned f2bf(float f) { unsigned u = __builtin_bit_cast(unsigned, f); return (u + 0x7fffu + ((u >> 16) & 1u)) >> 16; }
__device__ __forceinline__ unsigned pk2(float lo, float hi) { return f2bf(lo) | (f2bf(hi) << 16); }
#define XB_TMO      128
#define XB_XCNT(j)  (256  + 64 * (j))
#define XB_XSUB(j)  (1280 + 64 * (j))
#define XB_XGEN(j)  (2304 + 64 * (j))
#define XB_TOP      3328
#define XB_TOPGEN   3392
#define XCD_BAR_WORDS 3456
#define XB_SPIN_CAP (1u << 18)

__device__ __forceinline__ unsigned xb_ld(unsigned* p)              { return __hip_atomic_load(p, __ATOMIC_RELAXED, __HIP_MEMORY_SCOPE_AGENT); }
__device__ __forceinline__ unsigned xb_add(unsigned* p, unsigned v) { return __hip_atomic_fetch_add(p, v, __ATOMIC_RELAXED, __HIP_MEMORY_SCOPE_AGENT); }
__device__ __forceinline__ unsigned xb_xcc_id() { return (unsigned)__builtin_amdgcn_s_getreg((3 << 11) | 20) & 0xFu; }
#define XB_SPIN(cond, bar) do { unsigned _sp = 0; while (cond) { __builtin_amdgcn_s_sleep(1); \
    if ((++_sp & 255u) == 0u) { if (xb_ld(&(bar)[XB_TMO])) break; if (_sp > XB_SPIN_CAP) { atomicAdd(&(bar)[XB_TMO], 1u); break; } } } } while (0)

struct XcdBarrier {
    unsigned* bar; unsigned x;
    volatile LAS unsigned* st;
};

__device__ __forceinline__ XcdBarrier xcd_barrier_post(unsigned* bar, volatile LAS unsigned* st) {
    XcdBarrier b; b.bar = bar; b.x = xb_xcc_id(); b.st = st;
    if (threadIdx.x == 0) (void)xb_add(&bar[XB_XCNT(b.x)], 1u);
    return b;
}
__device__ __forceinline__ void xcd_barrier_complete(unsigned* bar, unsigned x, unsigned& nloc, unsigned& nx) {
    const unsigned G = gridDim.x * gridDim.y * gridDim.z;
    unsigned sum, cnt, mine, sp = 0u;
    for (;;) {
        sum = 0u; cnt = 0u; mine = 0u;
#pragma unroll
        for (unsigned j = 0; j < 16; ++j) { const unsigned c = xb_ld(&bar[XB_XCNT(j)]); sum += c; cnt += (c > 0u) ? 1u : 0u; mine = (j == x) ? c : mine; }
        if (sum == G) break;
        __builtin_amdgcn_s_sleep(1);
        if ((++sp & 255u) == 0u) { if (xb_ld(&bar[XB_TMO])) break; if (sp > XB_SPIN_CAP) { atomicAdd(&bar[XB_TMO], 1u); break; } }
    }
    nloc = mine > 0u ? mine : 1u; nx = cnt > 0u ? cnt : 1u;
}

__device__ __forceinline__ void xcd_barrier(const XcdBarrier& b) {
    asm volatile("s_waitcnt vmcnt(0)" ::: "memory");
    __syncthreads();
    if (threadIdx.x == 0) {
        unsigned* bar = b.bar;
        __builtin_amdgcn_s_waitcnt(0);
        unsigned nloc = b.st[0], nx = b.st[1];
        if (nloc == 0u) { xcd_barrier_complete(bar, b.x, nloc, nx); b.st[0] = nloc; b.st[1] = nx; }
        const unsigned old = xb_add(&bar[XB_XSUB(b.x)], 1u);
        const unsigned gen = old / nloc;
        if (old + 1u == (gen + 1u) * nloc) {
            __builtin_amdgcn_fence(__ATOMIC_RELEASE, "agent");
            asm volatile("s_waitcnt vmcnt(0)" ::: "memory");
            const unsigned og = xb_add(&bar[XB_TOP], 1u);
            const unsigned tg = og / nx;
            if (og + 1u == (tg + 1u) * nx) xb_add(&bar[XB_TOPGEN], 1u);
            else XB_SPIN(xb_ld(&bar[XB_TOPGEN]) == tg, bar);
            __builtin_amdgcn_fence(__ATOMIC_ACQUIRE, "agent");
            xb_add(&bar[XB_XGEN(b.x)], 1u);
            asm volatile("s_waitcnt vmcnt(0)" ::: "memory");
        } else {
            XB_SPIN(xb_ld(&bar[XB_XGEN(b.x)]) == gen, bar);
            __builtin_amdgcn_fence(__ATOMIC_ACQUIRE, "agent");
            asm volatile("s_waitcnt vmcnt(0)" ::: "memory");
        }
    }
    __syncthreads();
}
typedef float f32x16 __attribute__((ext_vector_type(16)));
struct Ctx {
    const float* const* in; float* outp; unsigned char* ws;
    int tid, lane, wave, vcu, G;
    DI const float* x() const { return in[0]; }
    DI const float* norm1_w() const { return in[1]; }
    DI const float* w_in() const { return in[2]; }
    DI const float* q_norm_w() const { return in[3]; }
    DI const float* k_norm_w() const { return in[4]; }
    DI const float* phi_k_pos() const { return in[5]; }
    DI const float* phi_k_w1() const { return in[6]; }
    DI const float* phi_k_w2() const { return in[7]; }
    DI const float* phi_v_pos() const { return in[8]; }
    DI const float* phi_v_w1() const { return in[9]; }
    DI const float* phi_v_w2() const { return in[10]; }
    DI const float* conv_w() const { return in[11]; }
    DI const float* conv_b() const { return in[12]; }
    DI const float* lru_wa() const { return in[13]; }
    DI const float* lru_ba() const { return in[14]; }
    DI const float* lru_wx() const { return in[15]; }
    DI const float* lru_bx() const { return in[16]; }
    DI const float* lru_lambda() const { return in[17]; }
    DI const float* w_nsa_up() const { return in[18]; }
    DI const float* w_lru_up() const { return in[19]; }
    DI const float* w_o() const { return in[20]; }
    DI const float* norm2_w() const { return in[21]; }
    DI const float* w_ff1() const { return in[22]; }
    DI const float* w_ff2() const { return in[23]; }
    DI float* out() const { return outp; }
    DI float* SS() const { return (float*)(ws + WS_SS); }
    DI float* ROPE_C() const { return (float*)(ws + WS_TAB); }
    DI float* ROPE_S() const { return (float*)(ws + WS_TAB + 128 * 1024); }
    DI float* CLAM() const { return (float*)(ws + WS_TAB + 256 * 1024); }
    DI float* PHIB() const { return (float*)(ws + WS_TAB + 260 * 1024); }
    DI bf16* WIN() const { return (bf16*)(ws + WS_WIN); }
    DI bf16* WM() const { return (bf16*)(ws + WS_WM); }
    DI bf16* WO() const { return (bf16*)(ws + WS_WO); }
    DI bf16* W1() const { return (bf16*)(ws + WS_W1); }
    DI bf16* W2() const { return (bf16*)(ws + WS_W2); }
    DI bf16* PK1() const { return (bf16*)(ws + WS_PK1); }
    DI bf16* PV1() const { return (bf16*)(ws + WS_PV1); }
    DI bf16* PK2() const { return (bf16*)(ws + WS_PK2); }
    DI bf16* PV2() const { return (bf16*)(ws + WS_PV2); }
    DI bf16* LWA() const { return (bf16*)(ws + WS_LWA); }
    DI bf16* LWX() const { return (bf16*)(ws + WS_LWX); }
    DI bf16* KC() const { return (bf16*)(ws + WS_KC); }
    DI bf16* VC() const { return (bf16*)(ws + WS_VC); }
    DI bf16* GN() const { return (bf16*)(ws + WS_GN); }
    DI bf16* XN() const { return (bf16*)(ws + WS_XN); }
    DI bf16* Q() const { return (bf16*)(ws + WS_Q); }
    DI bf16* KV() const { return (bf16*)(ws + WS_KV); }
    DI bf16* XR() const { return (bf16*)(ws + WS_XR); }
    DI bf16* YR() const { return (bf16*)(ws + WS_YR); }
    DI bf16* GM() const { return (bf16*)(ws + WS_GM); }
    DI bf16* COMB() const { return (bf16*)(ws + WS_COMB); }
    DI bf16* HB() const { return (bf16*)(ws + WS_HB); }
    DI bf16* MERGED() const { return (bf16*)(ws + WS_MERGED); }
    DI bf16* U() const { return (bf16*)(ws + WS_U); }
};
DI float bf2f(bf16 h) { return __uint_as_float((unsigned)h << 16); }
typedef float f32x2_g __attribute__((ext_vector_type(2))); typedef __bf16 bf16x2_g __attribute__((ext_vector_type(2)));
DI unsigned cvtpk2(float lo, float hi) { f32x2_g v = {lo, hi}; bf16x2_g b = __builtin_convertvector(v, bf16x2_g); return __builtin_bit_cast(unsigned, b); }
DI float wave_sum(float v) {
#pragma unroll
    for (int o = 1; o < 64; o <<= 1) v += __shfl_xor(v, o);
    return v;
}
DI float wave_max(float v) {
#pragma unroll
    for (int o = 1; o < 64; o <<= 1) v = fmaxf(v, __shfl_xor(v, o));
    return v;
}
DI float sigm(float x) { return __builtin_amdgcn_rcpf(1.0f + __expf(-x)); }
DI float gelu_tanh(float x) { return x * __builtin_amdgcn_rcpf(1.0f + __builtin_amdgcn_exp2f(x * (-2.3022082f - 0.10294325f * x * x))); }
#define MFMA16(a, b, c) __builtin_amdgcn_mfma_f32_16x16x32_bf16((a), (b), (c), 0, 0, 0)

struct ColMapId { DI int operator()(int n) const { return n; } };
struct ColMapIn { DI int operator()(int n) const { return n < 1280 ? n : (n < 5376 ? n + 24 : (n < 5400 ? n - 4096 : -1)); } };
template <class CM> DI void transpose_item(const float* W, int ldsrc, const float* rowscale, bf16* WT, int K, int kb, int nb, CM cm, LAS float* scr, int lane, float gscale = 1.0f) {
    const int k0 = 64 * kb, n0 = 32 * nb; const int c = cm(n0 + (lane & 31));
    float v[32];
#pragma unroll
    for (int i = 0; i < 32; ++i) { const int kk = 2 * i + (lane >> 5); v[i] = (c >= 0) ? W[(size_t)(k0 + kk) * ldsrc + c] : 0.f; }
    asm volatile("" ::: "memory");
#pragma unroll
    for (int i = 0; i < 32; ++i) { const int kk = 2 * i + (lane >> 5); float x = v[i] * gscale; if (rowscale) x *= rowscale[k0 + kk]; scr[kk * 33 + (lane & 31)] = x; }
    LDS_WAIT(); asm volatile("" ::: "memory");
    const int cc = lane & 7;
#pragma unroll
    for (int j = 0; j < 4; ++j) { const int n = (lane >> 3) + 8 * j; const LAS float* s = scr + (8 * cc) * 33 + n;
        v4u o; o.x = pk2(s[0 * 33], s[1 * 33]); o.y = pk2(s[2 * 33], s[3 * 33]); o.z = pk2(s[4 * 33], s[5 * 33]); o.w = pk2(s[6 * 33], s[7 * 33]);
        *(GAS v4u*)(WT + (size_t)(n0 + n) * K + k0 + 8 * cc) = o; }
    LDS_WAIT(); asm volatile("" ::: "memory");
}
DI void sincos_acc(double x, float& s_out, float& c_out) {
    const double TWO_PI = 6.283185307179586476925286766559, INV_2PI = 0.15915494309189533576888376337251, PI = 3.1415926535897932384626433832795;
    const double k = rint(x * INV_2PI); double r = x - k * TWO_PI; double csign = 1.0;
    if (r > 0.5 * PI) { r = PI - r; csign = -1.0; } else if (r < -0.5 * PI) { r = -PI - r; csign = -1.0; }
    const double z = r * r;
    double sp = -1.0 / 121645100408832000.0;
    sp = sp * z + 1.0 / 355687428096000.0; sp = sp * z - 1.0 / 1307674368000.0; sp = sp * z + 1.0 / 6227020800.0; sp = sp * z - 1.0 / 39916800.0;
    sp = sp * z + 1.0 / 362880.0; sp = sp * z - 1.0 / 5040.0; sp = sp * z + 1.0 / 120.0; sp = sp * z - 1.0 / 6.0; sp = sp * z + 1.0;
    double cp = 1.0 / 2432902008176640000.0;
    cp = cp * z - 1.0 / 6402373705728000.0; cp = cp * z + 1.0 / 20922789888000.0; cp = cp * z - 1.0 / 87178291200.0; cp = cp * z + 1.0 / 479001600.0;
    cp = cp * z - 1.0 / 3628800.0; cp = cp * z + 1.0 / 40320.0; cp = cp * z - 1.0 / 720.0; cp = cp * z + 1.0 / 24.0; cp = cp * z - 0.5; cp = cp * z + 1.0;
    s_out = (float)(sp * r); c_out = (float)(csign * cp);
}
DI void p0_prologue(const Ctx& C, LAS unsigned char* lds) {
    LAS float* scr = (LAS float*)(lds + C.wave * 16384);
    const int gw = C.vcu * NWAVES + C.wave, NGW = C.G * NWAVES, lane = C.lane;
    constexpr int I_IN = 16 * 176, I_NU = 8 * 32, I_LU = 16 * 32, I_WO = 16 * 32, I_W1 = 16 * 128, I_W2 = 64 * 32, I_P1 = 32 * 8, I_P2 = 4 * 2, I_LW = 8 * 8;
    constexpr int NITEMS = I_IN + 2 * I_P1 + 2 * I_P2 + 2 * I_LW;
    for (int it = gw; it < NITEMS; it += NGW) {
        int r = it;
        if (r < I_IN) { transpose_item(C.w_in(), 5400, nullptr, C.WIN(), 1024, r / 176, r % 176, ColMapIn(), scr, lane); continue; } r -= I_IN;
        if (r < 2 * I_P1) {
            const int kv = r / I_P1, q = r % I_P1; const float* w1 = kv ? C.phi_v_w1() : C.phi_k_w1(); bf16* dst = kv ? C.PV1() : C.PK1();
#pragma unroll
            for (int f4 = 0; f4 < 4; ++f4) { const int fi = q * 4 + f4, ks = fi >> 4, nt = fi & 15; const float* src = w1 + (size_t)(32 * ks + 8 * (lane >> 4)) * 256 + 16 * nt + (lane & 15);
                v4u o; o.x = pk2(src[0], src[256]); o.y = pk2(src[512], src[768]); o.z = pk2(src[1024], src[1280]); o.w = pk2(src[1536], src[1792]);
                *(v4u*)(dst + ((size_t)fi * 64 + lane) * 8) = o; }
            continue; } r -= 2 * I_P1;
        if (r < I_P2) { transpose_item(C.phi_k_w2(), 64, nullptr, C.PK2(), 256, r / 2, r % 2, ColMapId(), scr, lane); continue; } r -= I_P2;
        if (r < I_P2) { transpose_item(C.phi_v_w2(), 64, nullptr, C.PV2(), 256, r / 2, r % 2, ColMapId(), scr, lane); continue; } r -= I_P2;
        if (r < I_LW) { const int n = r >> 3, q = r & 7; transpose_item(C.lru_wa() + (size_t)n * 16384, 128, nullptr, C.LWA() + (size_t)n * 16384, 128, q >> 2, q & 3, ColMapId(), scr, lane, -1.4426950408889634f); continue; } r -= I_LW;
        { const int n = r >> 3, q = r & 7; transpose_item(C.lru_wx() + (size_t)n * 16384, 128, nullptr, C.LWX() + (size_t)n * 16384, 128, q >> 2, q & 3, ColMapId(), scr, lane, -1.4426950408889634f); }
    }
    {
        f32x4 wv[4];
#pragma unroll
        for (int j = 0; j < 4; ++j) wv[j] = ((const GAS f32x4*)C.norm1_w())[lane + 64 * j];
        f32x4 v[2][4], vn[2][4];
#pragma unroll
        for (int rr = 0; rr < 2; ++rr) { const int m0 = (gw + rr * NGW < T) ? gw + rr * NGW : gw;
#pragma unroll
            for (int j = 0; j < 4; ++j) v[rr][j] = ((const GAS f32x4*)(C.x() + (size_t)m0 * DM) + lane)[64 * j]; }
        for (int m = gw; m < T; m += 2 * NGW) {
#pragma unroll
            for (int rr = 0; rr < 2; ++rr) { const int mn = (m + (2 + rr) * NGW < T) ? m + (2 + rr) * NGW : m;
#pragma unroll
                for (int j = 0; j < 4; ++j) vn[rr][j] = ((const GAS f32x4*)(C.x() + (size_t)mn * DM) + lane)[64 * j]; }
#pragma unroll
            for (int rr = 0; rr < 2; ++rr) { const int mr = m + rr * NGW;
                if (mr < T) {
                    float s = 0.f;
#pragma unroll
                    for (int j = 0; j < 4; ++j) s += (v[rr][j].x * v[rr][j].x + v[rr][j].y * v[rr][j].y) + (v[rr][j].z * v[rr][j].z + v[rr][j].w * v[rr][j].w);
                    const float rstd = rsqrtf(wave_sum(s) * (1.0f / DM) + 1e-6f);
                    GAS unsigned long long* o8 = (GAS unsigned long long*)(C.XN() + (size_t)(mr >> 8) * (256 * DM) + (size_t)(lane >> 4) * (256 * 64) + (mr & 255) * 64 + (lane & 15) * 4);
#pragma unroll
                    for (int j = 0; j < 4; ++j) o8[(size_t)j * (4 * 256 * 64 / 4)] = (unsigned long long)cvtpk2(v[rr][j].x * rstd * wv[j].x, v[rr][j].y * rstd * wv[j].y) | ((unsigned long long)cvtpk2(v[rr][j].z * rstd * wv[j].z, v[rr][j].w * rstd * wv[j].w) << 32);
                } }
#pragma unroll
            for (int rr = 0; rr < 2; ++rr)
#pragma unroll
                for (int j = 0; j < 4; ++j) v[rr][j] = vn[rr][j];
        }
    }
    {
        const int gt = C.vcu * (NWAVES * 64) + C.tid, NGT = C.G * NWAVES * 64;
        for (int e = gt; e < T; e += NGT) C.SS()[e] = 0.f;
        for (int e = gt; e < 4096 * 8 + 1024; e += NGT) {
            if (e < 4096 * 8) {
                const int pos = e >> 3, i = e & 7;
                const unsigned invb[8] = {0x3f800000u, 0x3e4693afu, 0x3d1a08c8u, 0x3beef74eu, 0x3ab95d22u, 0x398fc8f8u, 0x385f10c5u, 0x372d07a8u};
                unsigned ib = invb[0];
#pragma unroll
                for (int q = 1; q < 8; ++q) ib = (i == q) ? invb[q] : ib;
                const float ang = (float)pos * __uint_as_float(ib);
                float s, c; sincos_acc((double)ang, s, c); C.ROPE_S()[e] = s; C.ROPE_C()[e] = c;
            } else {
                const int ch = e - 4096 * 8; const float lam = C.lru_lambda()[ch]; const float xx = __expf(-lam);
                const float sp = (xx < 0.03f) ? xx * (1.0f - xx * (0.5f - xx * (0.33333333f - 0.25f * xx))) : __logf(1.0f + xx);
                C.CLAM()[ch] = -8.0f * sp * 1.4426950408889634f;
            }
        }
    }
    for (int o = gw; o < 512; o += NGW) {
        const int kv = o >> 8, n = o & 255; const float* pos = kv ? C.phi_v_pos() : C.phi_k_pos(); const float* w1 = kv ? C.phi_v_w1() : C.phi_k_w1();
        float s = 0.f;
        for (int k = lane; k < 2048; k += 64) s += pos[k] * w1[(size_t)k * 256 + n];
        s = wave_sum(s);
        if (lane == 0) C.PHIB()[o] = s;
    }
}

#define DPPF(x, ctrl) __int_as_float(__builtin_amdgcn_update_dpp(0, __float_as_int(x), (ctrl), 0xF, 0xF, true))
struct NrTab { f32x4 nwa, nwb, ca, cb, sa, sb; };
DI void normrope8_prep(NrTab& Tb, const float* nw, const Ctx& C, int pos, int sub) {
    Tb.nwa = *(const f32x4*)(nw + sub * 8); Tb.nwb = *(const f32x4*)(nw + sub * 8 + 4);
    Tb.ca = *(const f32x4*)(C.ROPE_C() + pos * 8); Tb.cb = *(const f32x4*)(C.ROPE_C() + pos * 8 + 4);
    Tb.sa = *(const f32x4*)(C.ROPE_S() + pos * 8); Tb.sb = *(const f32x4*)(C.ROPE_S() + pos * 8 + 4);
}
DI void normrope8_apply(v4u& w, const NrTab& Tb, int sub, float scale) {
    float v[8] = {__uint_as_float(w.x << 16), __uint_as_float(w.x & 0xffff0000u), __uint_as_float(w.y << 16), __uint_as_float(w.y & 0xffff0000u),
                  __uint_as_float(w.z << 16), __uint_as_float(w.z & 0xffff0000u), __uint_as_float(w.w << 16), __uint_as_float(w.w & 0xffff0000u)};
    float ss = 0.f;
#pragma unroll
    for (int j = 0; j < 8; ++j) ss += v[j] * v[j];
    ss += DPPF(ss, 0xB1); ss += DPPF(ss, 0x4E); ss += DPPF(ss, 0x141);
    const float rstd = rsqrtf(ss * (1.0f / 64.0f) + 1e-6f);
#pragma unroll
    for (int j = 0; j < 8; ++j) v[j] = v[j] * rstd * ((j < 4) ? Tb.nwa[j & 3] : Tb.nwb[j & 3]);
#pragma unroll
    for (int j = 0; j < 8; ++j) { const float other = DPPF(v[j], 0xB1); const float c = (j < 4) ? Tb.ca[j & 3] : Tb.cb[j & 3], sn = (j < 4) ? Tb.sa[j & 3] : Tb.sb[j & 3];
        if (sub < 2) v[j] = (sub == 0) ? v[j] * c - other * sn : v[j] * c + other * sn; }
#pragma unroll
    for (int j = 0; j < 8; ++j) v[j] *= scale;
    w.x = cvtpk2(v[0], v[1]); w.y = cvtpk2(v[2], v[3]); w.z = cvtpk2(v[4], v[5]); w.w = cvtpk2(v[6], v[7]);
}
DI void normrope8(v4u& w, const float* nw, const Ctx& C, int pos, int sub, float scale) { NrTab Tb; normrope8_prep(Tb, nw, C, pos, sub); normrope8_apply(w, Tb, sub, scale); }
DI void normrope_pair(const Ctx& C, int pair) {
    const int lane = C.lane, sub = lane & 7;
    const int row = 2 * pair + (lane >> 5), vec = (lane >> 3) & 3;
    v4u* p = (v4u*)(C.KV() + (size_t)row * 768 + ((vec < 2) ? 256 : 512) + (vec & 1) * 64 + sub * 8); v4u w = *p;
    normrope8(w, C.k_norm_w() + ((vec < 2) ? 64 : 128), C, row & (SEQ - 1), sub, 1.0f); *p = w;
}

struct WconvItem { const float* src; const float* rs; bf16* dst; int ldn; };
DI bool wconv_decode(const Ctx& C, int idx, int lane, WconvItem& I) {
    int r = idx; const float* W; bf16* D; int N, pitch, coff = 0; const float* rsc = nullptr;
    if (r < 1024) { W = C.w_nsa_up(); D = C.WM(); N = 1024; pitch = 1536; }
    else if ((r -= 1024) < 2048) { W = C.w_lru_up(); D = C.WM(); N = 1024; pitch = 1536; coff = 512; }
    else if ((r -= 2048) < 2048) { W = C.w_o(); D = C.WO(); N = 1024; pitch = 1024; }
    else if ((r -= 2048) < 8192) { W = C.w_ff1(); D = C.W1(); N = 4096; pitch = 1024; rsc = C.norm2_w(); }
    else if ((r -= 8192) < 8192) { W = C.w_ff2(); D = C.W2(); N = 1024; pitch = 4096; }
    else return false;
    const int nb = N / 64, kb = r / nb, n = (r % nb) * 64 + lane, k0 = 8 * kb;
    I.src = W + (size_t)k0 * N + n; I.rs = rsc ? rsc + k0 : nullptr; I.dst = D + (size_t)n * pitch + coff + k0; I.ldn = N; return true;
}
constexpr int LRU_XROW = 272, LRU_WREG = 35 * 272 + 2048 + 2048;
DI void lru_strip(const Ctx& C, int strip, LAS unsigned char* lds) {
    const int tid = C.tid, lane = C.lane, wave = C.wave, l15 = lane & 15, lg = lane >> 4;
    const int b = strip >> 5, n = (strip >> 2) & 7, eq = strip & 3;
    LAS float* xch = (LAS float*)lds;
    LAS bf16x8* wf = (LAS bf16x8*)(lds + 4096);
    LAS unsigned char* XW = lds + 4096 + 16384 + wave * LRU_WREG;
    LAS unsigned char* YW = XW + 35 * LRU_XROW;
    LAS unsigned char* OW = YW + 2048;
    LAS float* cw = (LAS float*)(lds + 4096 + 16384);
    for (int i = tid; i < 640; i += NWAVES * 64) cw[i] = (i < 512) ? C.conv_w()[(i >> 7) * 1024 + n * 128 + (i & 127)] : C.conv_b()[n * 128 + (i - 512)];
    for (int i = tid; i < 1024; i += NWAVES * 64) { const int fl = i & 63, fi = i >> 6, gate = fi >> 3, nt = (fi >> 2) & 1, ks = fi & 3;
        const size_t o = (size_t)(n * 128 + 32 * eq + 16 * nt + (fl & 15)) * 128 + 32 * ks + 8 * (fl >> 4);
        wf[i] = *(const bf16x8*)((gate ? C.LWX() : C.LWA()) + o); }
    bf16x8 Id[2];
#pragma unroll
    for (int nt = 0; nt < 2; ++nt) {
#pragma unroll
        for (int j = 0; j < 8; ++j) Id[nt][j] = (8 * lg + j == 16 * nt + l15) ? (short)0x3F80 : (short)0;
    }
    float ba[2], bx[2], cl[2], hprev[2] = {0.f, 0.f};
#pragma unroll
    for (int nt = 0; nt < 2; ++nt) { const int ch = n * 128 + 32 * eq + 16 * nt + l15; ba[nt] = -1.4426950408889634f * C.lru_ba()[ch]; bx[nt] = -1.4426950408889634f * C.lru_bx()[ch]; cl[nt] = C.CLAM()[ch]; }
    __syncthreads();
    float cwl[5], cwh[5];
#pragma unroll
    for (int tp = 0; tp < 5; ++tp) { cwl[tp] = cw[tp * 128 + 2 * lane]; cwh[tp] = cw[tp * 128 + 2 * lane + 1]; }
    __syncthreads();
    const char* xbase = (const char*)(C.XR() + (size_t)b * SEQ * 1024 + n * 128);
    const char* ybase = (const char*)(C.YR() + (size_t)b * SEQ * 1024 + n * 128 + 32 * eq);
    char* obase = (char*)(C.COMB() + (size_t)(b * 16) * (256 * 1536) + (size_t)(8 + 2 * n + (eq >> 1)) * (256 * 64) + (eq & 1) * 32);
    v4u xr[9], yr[2];
#define LRU_LOAD(c_) do { const int tok0 = 256 * (c_) + 32 * wave - 3; \
        _Pragma("unroll") for (int k = 0; k < 9; ++k) { const int p = lane + 64 * k, tk = tok0 + (p >> 4); \
            v4u v = {0u, 0u, 0u, 0u}; if (p < 560 && tk >= 0) v = *(const v4u*)(xbase + ((unsigned)tk * 2048u + (unsigned)(p & 15) * 16u)); xr[k] = v; } } while (0)
#define LRU_LOADY(c_) do { _Pragma("unroll") for (int k = 0; k < 2; ++k) { const int q = lane + 64 * k; yr[k] = *(const v4u*)(ybase + ((unsigned)(256 * (c_) + 32 * wave + (q >> 2)) * 2048u + (unsigned)(q & 3) * 16u)); } } while (0)
#define LRU_STORE() do { \
        _Pragma("unroll") for (int k = 0; k < 9; ++k) { const int p = lane + 64 * k; if (p < 560) *(LAS v4u*)(XW + (p >> 4) * LRU_XROW + (p & 15) * 16) = xr[k]; } \
        _Pragma("unroll") for (int k = 0; k < 2; ++k) { const int q = lane + 64 * k; *(LAS v4u*)(YW + (q >> 2) * 64 + (q & 3) * 16) = yr[k]; } } while (0)
    LRU_LOAD(0); LRU_LOADY(0); LRU_STORE();
    LDS_WAIT(); asm volatile("" ::: "memory");
    v4u nr_w = {0u, 0u, 0u, 0u}; v4u* nr_p = nullptr; NrTab nr_T;
#pragma unroll 1
    for (int chunk = 0; chunk < 16; ++chunk) {
        if ((chunk & 1) == 0) { const int pair = 64 * strip + 8 * wave + (chunk >> 1), row = 2 * pair + (lane >> 5), vec = (lane >> 3) & 3;
            nr_p = (v4u*)(C.KV() + (size_t)row * 768 + ((vec < 2) ? 256 : 512) + (vec & 1) * 64 + (lane & 7) * 8); nr_w = *nr_p; }
        else { const int pair = 64 * strip + 8 * wave + (chunk >> 1), row = 2 * pair + (lane >> 5), vec = (lane >> 3) & 3;
            normrope8_prep(nr_T, C.k_norm_w() + ((vec < 2) ? 64 : 128), C, row & (SEQ - 1), lane & 7); }
        bf16x8 Af[2][4];
#pragma unroll
        for (int m = 0; m < 2; ++m) { unsigned xv[19];
#pragma unroll
          for (int r = 0; r < 19; ++r) xv[r] = *(const LAS unsigned*)(XW + (16 * m + r) * LRU_XROW + 4 * lane);
#pragma unroll
          for (int t = 0; t < 16; ++t) { float alo = cwl[4], ahi = cwh[4];
#pragma unroll
              for (int tp = 0; tp < 4; ++tp) { alo += cwl[tp] * __uint_as_float(xv[t + tp] << 16); ahi += cwh[tp] * __uint_as_float(xv[t + tp] & 0xffff0000u); }
              *(LAS unsigned*)(XW + (16 * m + t) * LRU_XROW + 4 * lane) = cvtpk2(alo, ahi); }
          LDS_WAIT(); asm volatile("" ::: "memory");
#pragma unroll
          for (int ks = 0; ks < 4; ++ks) Af[m][ks] = *(const LAS bf16x8*)(XW + (16 * m + l15) * LRU_XROW + ks * 64 + lg * 16);
          asm volatile("" : "+v"(Af[m][0]), "+v"(Af[m][1]), "+v"(Af[m][2]), "+v"(Af[m][3]) :: "memory");
        }
        if (chunk + 1 < 16) LRU_LOAD(chunk + 1);
        float Ap[2][2][4], Hp[2][2][4], Aex[2][2], Hex[2][2], Atot[2][2], Htot[2][2];
#pragma unroll
        for (int m = 0; m < 2; ++m) {
            const bf16x8 As = (eq == 0) ? Af[m][0] : (eq == 1) ? Af[m][1] : (eq == 2) ? Af[m][2] : Af[m][3];
#pragma unroll
            for (int nt = 0; nt < 2; ++nt) {
                f32x4 ga = {ba[nt], ba[nt], ba[nt], ba[nt]}, gx = {bx[nt], bx[nt], bx[nt], bx[nt]};
#pragma unroll
                for (int ks = 0; ks < 4; ++ks) { ga = MFMA16(Af[m][ks], wf[((0 * 2 + nt) * 4 + ks) * 64 + lane], ga); gx = MFMA16(Af[m][ks], wf[((1 * 2 + nt) * 4 + ks) * 64 + lane], gx); }
                const f32x4 xc = MFMA16(As, Id[nt], ((f32x4){0.f, 0.f, 0.f, 0.f}));
                float A = 1.f, H = 0.f;
#pragma unroll
                for (int r = 0; r < 4; ++r) {
                    const float ra = __builtin_amdgcn_rcpf(1.0f + __builtin_amdgcn_exp2f(ga[r])), ix = __builtin_amdgcn_rcpf(1.0f + __builtin_amdgcn_exp2f(gx[r]));
                    const float e2 = cl[nt] * ra, a = __builtin_amdgcn_exp2f(e2);
                    const float om = __builtin_fmaf(-a, a, 1.0f);
                    const float bt = __builtin_amdgcn_sqrtf(om) * (ix * xc[r]);
                    H = a * H + bt; A = a * A; Ap[m][nt][r] = A; Hp[m][nt][r] = H;
                }
                { const auto sa = __builtin_amdgcn_permlane16_swap(__float_as_uint(A), __float_as_uint(A), false, false), sh = __builtin_amdgcn_permlane16_swap(__float_as_uint(H), __float_as_uint(H), false, false);
                  const bool odd = (lg & 1) != 0, up = (lg >= 2);
                  const float PA = __uint_as_float(odd ? sa[0] : sa[1]), PH = __uint_as_float(odd ? sh[0] : sh[1]);
                  const float TA = A * PA, TH = odd ? (A * PH + H) : (PA * H + PH);
                  const auto qa = __builtin_amdgcn_permlane32_swap(__float_as_uint(TA), __float_as_uint(TA), false, false), qh = __builtin_amdgcn_permlane32_swap(__float_as_uint(TH), __float_as_uint(TH), false, false);
                  const float QA = __uint_as_float(up ? qa[0] : qa[1]), QH = __uint_as_float(up ? qh[0] : qh[1]);
                  float Ae = 1.f, He = 0.f;
                  if (lg == 1) { Ae = PA; He = PH; } else if (lg == 2) { Ae = QA; He = QH; } else if (lg == 3) { Ae = QA * PA; He = PA * QH + PH; }
                  Aex[m][nt] = Ae; Hex[m][nt] = He;
                  Atot[m][nt] = TA * QA; Htot[m][nt] = up ? (TA * QH + TH) : (QA * TH + QH); }
                asm volatile("" : "+v"(Atot[m][nt]), "+v"(Htot[m][nt]) :: "memory");
            }
        }
        LAS float* xp = xch + (chunk & 1) * 512;
        if (lg == 0) {
#pragma unroll
            for (int nt = 0; nt < 2; ++nt) { xp[(wave * 32 + 16 * nt + l15) * 2] = Atot[0][nt] * Atot[1][nt]; xp[(wave * 32 + 16 * nt + l15) * 2 + 1] = Atot[1][nt] * Htot[0][nt] + Htot[1][nt]; }
        }
        if (chunk + 1 < 16) LRU_LOADY(chunk + 1);
        __syncthreads();
#pragma unroll
        for (int nt = 0; nt < 2; ++nt) { float h = hprev[nt], hw = h;
#pragma unroll
            for (int w2 = 0; w2 < 8; ++w2) { if (w2 == wave) hw = h; const float Aw = xp[(w2 * 32 + 16 * nt + l15) * 2], Hw = xp[(w2 * 32 + 16 * nt + l15) * 2 + 1]; h = Aw * h + Hw; }
            hprev[nt] = h;
#pragma unroll
            for (int m = 0; m < 2; ++m) { const float hg = Aex[m][nt] * hw + Hex[m][nt];
#pragma unroll
                for (int r = 0; r < 4; ++r) { const float hv = Ap[m][nt][r] * hg + Hp[m][nt][r]; const float yv = bf2f(*(const LAS bf16*)(YW + (16 * m + 4 * lg + r) * 64 + 32 * nt + 2 * l15));
                    *(LAS bf16*)(OW + (16 * m + 4 * lg + r) * 64 + 32 * nt + 2 * l15) = (bf16)(cvtpk2(hv * gelu_tanh(yv), 0.f) & 0xffffu); }
                hw = Atot[m][nt] * hw + Htot[m][nt]; } }
        LDS_WAIT(); asm volatile("" ::: "memory");
#pragma unroll
        for (int k = 0; k < 2; ++k) { const int q = lane + 64 * k; const v4u ov = *(const LAS v4u*)(OW + q * 16);
            *(v4u*)(obase + ((unsigned)chunk * (256u * 1536u * 2u) + (unsigned)(32 * wave + (q >> 2)) * 128u + (unsigned)(q & 3) * 16u)) = ov; }
        if (chunk + 1 < 16) LRU_STORE();
        if (chunk & 1) { normrope8_apply(nr_w, nr_T, lane & 7, 1.0f); *nr_p = nr_w; }
        LDS_WAIT(); asm volatile("" ::: "memory");
    }
#undef LRU_LOAD
#undef LRU_LOADY
#undef LRU_STORE
    __syncthreads();
}

DI void rope_norm_lane(float& v, const float* nw, const Ctx& C, int pos, int lane, bool do_norm) {
    if (do_norm) { const float ss = wave_sum(v * v); v = v * rsqrtf(ss * (1.0f / 64.0f) + 1e-6f) * nw[lane]; }
    const float other = __shfl_xor(v, 8);
    if (lane < 16) { const float c = C.ROPE_C()[pos * 8 + (lane & 7)], s = C.ROPE_S()[pos * 8 + (lane & 7)]; v = (lane < 8) ? v * c - other * s : v * c + other * s; }
}
DI void compress_item(const Ctx& C, int item, LAS unsigned char* lds) {
    const int tid = C.tid, lane = C.lane, wave = C.wave, l15 = lane & 15, lg = lane >> 4;
    const int kv = item >> 7, b = (item >> 4) & 7, g = (item >> 3) & 1, i0 = (item & 7) * 32;
    const bf16* W1F = kv ? C.PV1() : C.PK1(); const bf16* W2T = kv ? C.PV2() : C.PK2();
    LAS unsigned char* AS = lds;
    LAS bf16* hid = (LAS bf16*)(lds + 67584);
    LAS float* outs = (LAS float*)(lds + 67584 + 32 * 264 * 2);
    { const char* base = (const char*)(C.KV() + (size_t)(b * SEQ + 16 * i0) * 768 + kv * 128 + g * 64);
      v4u st[9];
#pragma unroll
      for (int k = 0; k < 9; ++k) { const int p = tid + 512 * k, r = p >> 3; v4u v = {0u, 0u, 0u, 0u}; if (p < 4224 && 16 * i0 + r < SEQ) v = *(const v4u*)(base + (size_t)r * 1536 + (p & 7) * 16); st[k] = v; }
#pragma unroll
      for (int k = 0; k < 9; ++k) { const int p = tid + 512 * k, r = p >> 3; if (p < 4224) *(LAS v4u*)(AS + r * 128 + (((p & 7) ^ ((r >> 4) & 7)) * 16)) = st[k]; } }
    const float bi0 = C.PHIB()[kv * 256 + 32 * wave + l15], bi1 = C.PHIB()[kv * 256 + 32 * wave + 16 + l15];
    int arow[2];
#pragma unroll
    for (int m = 0; m < 2; ++m) { const int bl = (i0 + 16 * m + l15 < 255) ? 16 * m + l15 : 254 - i0; arow[m] = 16 * bl; }
    const bf16* bp = W1F + ((size_t)(2 * wave) * 64 + lane) * 8;
    f32x4 acc[2][2];
#pragma unroll
    for (int m = 0; m < 2; ++m)
#pragma unroll
        for (int t = 0; t < 2; ++t) acc[m][t] = (f32x4){0.f, 0.f, 0.f, 0.f};
    bf16x8 fb0[4][2], fb1[4][2];
#define CMP_LOAD(FB, kb_) do { _Pragma("unroll") for (int s_ = 0; s_ < 4; ++s_) { const int ks = 4 * (kb_) + s_; \
        FB[s_][0] = *(const bf16x8*)(bp + (size_t)(ks * 16) * 512); FB[s_][1] = *(const bf16x8*)(bp + (size_t)(ks * 16 + 1) * 512); } } while (0)
#define CMP_MMA(FB, kb_) do { _Pragma("unroll") for (int s_ = 0; s_ < 4; ++s_) { const int ks = 4 * (kb_) + s_, j = ks >> 1, ch = (ks & 1) * 4 + lg; \
        const int r0 = arow[0] + j, r1 = arow[1] + j; \
        const bf16x8 a0 = *(const LAS bf16x8*)(AS + r0 * 128 + ((ch ^ ((r0 >> 4) & 7)) * 16)), a1 = *(const LAS bf16x8*)(AS + r1 * 128 + ((ch ^ ((r1 >> 4) & 7)) * 16)); \
        acc[0][0] = MFMA16(a0, FB[s_][0], acc[0][0]); acc[0][1] = MFMA16(a0, FB[s_][1], acc[0][1]); acc[1][0] = MFMA16(a1, FB[s_][0], acc[1][0]); acc[1][1] = MFMA16(a1, FB[s_][1], acc[1][1]); } } while (0)
    CMP_LOAD(fb0, 0);
    __syncthreads();
#pragma unroll 1
    for (int kb = 0; kb < 16; kb += 2) {
        CMP_LOAD(fb1, kb + 1); asm volatile("" ::: "memory");
        CMP_MMA(fb0, kb);
        asm volatile("" : "+v"(acc[0][0]), "+v"(acc[0][1]), "+v"(acc[1][0]), "+v"(acc[1][1]) :: "memory");
        if (kb + 2 < 16) CMP_LOAD(fb0, kb + 2);
        asm volatile("" ::: "memory");
        CMP_MMA(fb1, kb + 1);
        asm volatile("" : "+v"(acc[0][0]), "+v"(acc[0][1]), "+v"(acc[1][0]), "+v"(acc[1][1]) :: "memory");
    }
#undef CMP_LOAD
#undef CMP_MMA
#ifdef PROBE_TS
    if (blockIdx.x == 0 && C.tid == 0) ((unsigned long long*)(C.ws + 256))[11] = rt();
#endif
    const int m2 = wave >> 2, nt2 = wave & 3;
    bf16x8 w2f[8];
#pragma unroll
    for (int ks = 0; ks < 8; ++ks) w2f[ks] = *(const bf16x8*)(W2T + (size_t)(16 * nt2 + l15) * 256 + ks * 32 + 8 * lg);
#pragma unroll
    for (int m = 0; m < 2; ++m)
#pragma unroll
        for (int r = 0; r < 4; ++r) { hid[(16 * m + 4 * lg + r) * 264 + 32 * wave + l15] = (bf16)f2bf(gelu_tanh(acc[m][0][r] + bi0)); hid[(16 * m + 4 * lg + r) * 264 + 32 * wave + 16 + l15] = (bf16)f2bf(gelu_tanh(acc[m][1][r] + bi1)); }
    __syncthreads();
    { f32x4 acc2 = {0.f, 0.f, 0.f, 0.f};
#pragma unroll
      for (int ks = 0; ks < 8; ++ks) { const bf16x8 a = *(const LAS bf16x8*)(hid + (16 * m2 + l15) * 264 + ks * 32 + 8 * lg); acc2 = MFMA16(a, w2f[ks], acc2); }
#pragma unroll
      for (int r = 0; r < 4; ++r) outs[(16 * m2 + 4 * lg + r) * 64 + 16 * nt2 + l15] = acc2[r]; }
    float rc[4], rsn[4]; const float nw = C.k_norm_w()[lane];
#pragma unroll
    for (int rr = 0; rr < 4; ++rr) { const int i = i0 + 4 * wave + rr, pos = (i < 255) ? 16 * i + 31 : 31; rc[rr] = C.ROPE_C()[pos * 8 + (lane & 7)]; rsn[rr] = C.ROPE_S()[pos * 8 + (lane & 7)]; }
    __syncthreads();
#pragma unroll
    for (int rr = 0; rr < 4; ++rr) { const int row = 4 * wave + rr, i = i0 + row;
        float v = outs[row * 64 + lane];
        if (kv == 0) { const float ss = wave_sum(v * v); v = v * rsqrtf(ss * (1.0f / 64.0f) + 1e-6f) * nw;
            const float other = __shfl_xor(v, 8);
            if (lane < 16) v = (lane < 8) ? v * rc[rr] - other * rsn[rr] : v * rc[rr] + other * rsn[rr]; }
        if (i < 255) (kv ? C.VC() : C.KC())[(size_t)((b * 2 + g) * 256 + i) * 64 + lane] = (bf16)f2bf(v); }
    __syncthreads();
}

#if defined(NAIVE_ATTN) || defined(PROBE_ATTN_CHECK)
DI void dot4(const bf16* kp, const LAS float* qs, float (&d)[4]) {
    d[0] = d[1] = d[2] = d[3] = 0.f;
#pragma unroll 1
    for (int c = 0; c < 8; ++c) {
        const v4u kw = *(const v4u*)(kp + 8 * c);
        const float k0 = __uint_as_float(kw.x << 16), k1 = __uint_as_float(kw.x & 0xffff0000u), k2 = __uint_as_float(kw.y << 16), k3 = __uint_as_float(kw.y & 0xffff0000u);
        const float k4 = __uint_as_float(kw.z << 16), k5 = __uint_as_float(kw.z & 0xffff0000u), k6 = __uint_as_float(kw.w << 16), k7 = __uint_as_float(kw.w & 0xffff0000u);
#pragma unroll
        for (int h = 0; h < 4; ++h) { const f32x4 qa = *(const LAS f32x4*)(qs + h * 64 + 8 * c), qb = *(const LAS f32x4*)(qs + h * 64 + 8 * c + 4);
            d[h] += (k0 * qa[0] + k1 * qa[1]) + (k2 * qa[2] + k3 * qa[3]) + (k4 * qb[0] + k5 * qb[1]) + (k6 * qb[2] + k7 * qb[3]); }
    }
}
DI void attend_blocks(const Ctx& C, int b, int t, unsigned long long mask, int kcol, int vcol, int lo, const LAS float* qs, LAS float* ps, float (&o)[4]) {
    const int lane = C.lane;
    float mloc[4] = {-1e30f, -1e30f, -1e30f, -1e30f};
    for (unsigned long long mm = mask; mm; mm &= mm - 1) {
        asm volatile("" ::: "memory");
        const int j = __builtin_ctzll(mm), tok = 64 * j + lane; const bool valid = tok >= lo && tok <= t;
        float d[4]; dot4(C.KV() + (size_t)(b * SEQ + tok) * 768 + kcol, qs, d);
#pragma unroll
        for (int h = 0; h < 4; ++h) if (valid) mloc[h] = fmaxf(mloc[h], d[h]);
    }
    float mx[4], lp[4] = {0.f, 0.f, 0.f, 0.f};
#pragma unroll
    for (int h = 0; h < 4; ++h) { mx[h] = wave_max(mloc[h]); o[h] = 0.f; }
    for (unsigned long long mm = mask; mm; mm &= mm - 1) {
        asm volatile("" ::: "memory");
        const int j = __builtin_ctzll(mm), tok = 64 * j + lane; const bool valid = tok >= lo && tok <= t;
        float d[4]; dot4(C.KV() + (size_t)(b * SEQ + tok) * 768 + kcol, qs, d);
#pragma unroll
        for (int h = 0; h < 4; ++h) { const float p = valid ? exp2f(d[h] - mx[h]) : 0.f; lp[h] += p; ps[h * 64 + lane] = p; }
        LDS_WAIT(); asm volatile("" ::: "memory");
        const bf16* vp = C.KV() + (size_t)(b * SEQ + 64 * j) * 768 + vcol + lane;
#pragma unroll 4
        for (int kk = 0; kk < 64; ++kk) { const float v = bf2f(vp[(size_t)kk * 768]);
#pragma unroll
            for (int h = 0; h < 4; ++h) o[h] += ps[h * 64 + kk] * v; }
        LDS_WAIT(); asm volatile("" ::: "memory");
    }
#pragma unroll
    for (int h = 0; h < 4; ++h) o[h] /= wave_sum(lp[h]);
}
DI void attn_naive(const Ctx& C, int qidx, LAS float* wl, bf16* onsa) {
    const int lane = C.lane, b = qidx >> 13, g = (qidx >> 12) & 1, t = qidx & (SEQ - 1), row = b * SEQ + t;
    LAS float* qs = wl; LAS float* ps = wl + 256; LAS float* psum = wl + 256 + 1024;
#pragma unroll
    for (int h = 0; h < 4; ++h) { float v = bf2f(C.Q()[(size_t)row * 512 + (g * 4 + h) * 64 + lane]); rope_norm_lane(v, C.q_norm_w(), C, t, lane, true); qs[h * 64 + lane] = bf2f((bf16)(cvtpk2(v * 0.18033688011112042f, 0.f) & 0xffffu)); }
#pragma unroll
    for (int i = 0; i < 4; ++i) psum[i * 64 + lane] = 0.f;
    LDS_WAIT(); asm volatile("" ::: "memory");
    float gate[3][4], otot[4] = {0.f, 0.f, 0.f, 0.f};
#pragma unroll
    for (int br = 0; br < 3; ++br)
#pragma unroll
        for (int h = 0; h < 4; ++h) gate[br][h] = sigm(bf2f(C.GN()[(size_t)row * 32 + br * 8 + g * 4 + h]));
    const int nv = (t >= 31) ? ((t - 31) >> 4) + 1 : 0;
    if (nv > 0) {
        float sc[4][4];
#pragma unroll
        for (int rd = 0; rd < 4; ++rd) { asm volatile("" ::: "memory"); const int n = rd * 64 + lane; const bool valid = n < nv;
            float d[4]; dot4(C.KC() + (size_t)((b * 2 + g) * 256 + (valid ? n : 0)) * 64, qs, d);
#pragma unroll
            for (int h = 0; h < 4; ++h) sc[rd][h] = valid ? d[h] : -1e30f; }
        float pacc[4] = {0.f, 0.f, 0.f, 0.f};
#pragma unroll
        for (int h = 0; h < 4; ++h) {
            const float m = wave_max(fmaxf(fmaxf(sc[0][h], sc[1][h]), fmaxf(sc[2][h], sc[3][h])));
            float e[4], l = 0.f;
#pragma unroll
            for (int rd = 0; rd < 4; ++rd) { e[rd] = (rd * 64 + lane < nv) ? exp2f(sc[rd][h] - m) : 0.f; l += e[rd]; }
            const float inv = 1.0f / wave_sum(l);
#pragma unroll
            for (int rd = 0; rd < 4; ++rd) { const float p = e[rd] * inv; ps[h * 256 + rd * 64 + lane] = p; pacc[rd] += p; }
        }
#pragma unroll
        for (int rd = 0; rd < 4; ++rd) psum[rd * 64 + lane] = pacc[rd];
        LDS_WAIT(); asm volatile("" ::: "memory");
        float oc[4] = {0.f, 0.f, 0.f, 0.f};
        const bf16* vp = C.VC() + (size_t)((b * 2 + g) * 256) * 64 + lane;
        for (int n = 0; n < nv; ++n) { const float v = bf2f(vp[n * 64]);
#pragma unroll
            for (int h = 0; h < 4; ++h) oc[h] += ps[h * 256 + n] * v; }
#pragma unroll
        for (int h = 0; h < 4; ++h) otot[h] += gate[0][h] * oc[h];
    }
    LDS_WAIT(); asm volatile("" ::: "memory");
    const int cur = t >> 6;
    float imp = 0.f;
#pragma unroll
    for (int k = -1; k <= 3; ++k) { const int n = 4 * lane + k; if (n >= 0 && n < 255) imp += psum[n]; }
    const float score = (lane > cur) ? -1e30f : ((lane == 0 || lane == cur || lane == cur - 1) ? 1e4f : imp);
    int cnt = 0;
#pragma unroll 4
    for (int jj = 0; jj < 64; ++jj) { const float sj = __shfl(score, jj); cnt += (sj > score || (sj == score && jj < lane)) ? 1 : 0; }
    unsigned long long sel = __ballot(cnt < 16);
    sel &= (cur == 63) ? ~0ull : ((1ull << (cur + 1)) - 1ull);
    LDS_WAIT(); asm volatile("" ::: "memory");
    float o[4];
    attend_blocks(C, b, t, sel, 256 + g * 64, 384 + g * 64, 0, qs, ps, o);
#pragma unroll
    for (int h = 0; h < 4; ++h) otot[h] += gate[1][h] * o[h];
    const int lo = (t >= 511) ? t - 511 : 0;
    unsigned long long wm = 0ull;
    for (int j = lo >> 6; j <= cur; ++j) wm |= 1ull << j;
    attend_blocks(C, b, t, wm, 512 + g * 64, 640 + g * 64, lo, qs, ps, o);
#pragma unroll
    for (int h = 0; h < 4; ++h) { otot[h] += gate[2][h] * o[h]; onsa[(size_t)row * 1536 + (g * 4 + h) * 64 + lane] = (bf16)f2bf(otot[h]); }
}
#endif
namespace fa {
typedef short s16x4 __attribute__((ext_vector_type(4)));
typedef short v4i16_t __attribute__((ext_vector_type(4)));
typedef float f32x2_t __attribute__((ext_vector_type(2)));
typedef __bf16 bf16x2_t __attribute__((ext_vector_type(2)));
typedef LAS const char* lds_cptr;
constexpr int L_K = 0, L_V = 16384, L_WSF = 40960, L_PW = 43008, L_SEL = 108544, L_END = 109056;
constexpr float NEGF = -1e30f, THR = 8.0f;
DI int crow(int r, int hi) { return (r & 3) + 8 * (r >> 2) + 4 * hi; }
DI unsigned cvtpk(float lo, float hi) { f32x2_t v = {lo, hi}; bf16x2_t b = __builtin_convertvector(v, bf16x2_t); return __builtin_bit_cast(unsigned, b); }
DI s16x4 vtr(lds_cptr p) { return __builtin_bit_cast(s16x4, __builtin_amdgcn_ds_read_tr16_b64_v4i16((LAS v4i16_t*)p)); }
DI float swap_max(float m) { auto rr = __builtin_amdgcn_permlane32_swap(__float_as_uint(m), __float_as_uint(m), false, false); return fmaxf(__uint_as_float(rr[0]), __uint_as_float(rr[1])); }
DI float swap_sum(float m) { auto rr = __builtin_amdgcn_permlane32_swap(__float_as_uint(m), __float_as_uint(m), false, false); return __uint_as_float(rr[0]) + __uint_as_float(rr[1]); }
DI float quad_sum(float x) {
    float y = __int_as_float(__builtin_amdgcn_update_dpp(0, __float_as_int(x), 0xB1, 0xF, 0xF, true)); x += y;
    y = __int_as_float(__builtin_amdgcn_update_dpp(0, __float_as_int(x), 0x4E, 0xF, 0xF, true)); return x + y; }
#define FA_MFMA32(a, b, c) __builtin_amdgcn_mfma_f32_32x32x16_bf16((a), (b), (c), 0, 0, 0)

DI void qkt(f32x16& p0, f32x16& p1, lds_cptr kslot, const bf16x8 (&qr)[4], const f32x16& cinit, int r32, int hi) {
    const lds_cptr kb = kslot + hi * 1024 + r32 * 16;
    bf16x8 kf[8];
#pragma unroll
    for (int d0 = 0; d0 < 4; ++d0) { kf[2 * d0] = *(const LAS bf16x8*)(kb + d0 * 2048); kf[2 * d0 + 1] = *(const LAS bf16x8*)(kb + d0 * 2048 + 512); }
    asm volatile("" : "+v"(kf[0]), "+v"(kf[1]), "+v"(kf[2]), "+v"(kf[3]), "+v"(kf[4]), "+v"(kf[5]), "+v"(kf[6]), "+v"(kf[7]));
    p0 = cinit; p1 = cinit;
#pragma unroll
    for (int d0 = 0; d0 < 4; ++d0) { p0 = FA_MFMA32(kf[2 * d0], qr[d0], p0); p1 = FA_MFMA32(kf[2 * d0 + 1], qr[d0], p1); }
}
DI void v_load(bf16x8 (&vf)[8], lds_cptr vslot, int lane, int hi) {
    const lds_cptr vb = vslot + ((lane >> 4) & 1) * 32 + (lane & 3) * 8 + (4 * hi + ((lane & 15) >> 2)) * 64;
#pragma unroll
    for (int d0 = 0; d0 < 2; ++d0)
#pragma unroll
        for (int ks = 0; ks < 4; ++ks) {
            const s16x4 lo = vtr(vb + d0 * 4096 + ks * 1024), hh = vtr(vb + d0 * 4096 + ks * 1024 + 512);
            vf[d0 * 4 + ks] = (bf16x8){lo[0], lo[1], lo[2], lo[3], hh[0], hh[1], hh[2], hh[3]};
        }
    asm volatile("" : "+v"(vf[0]), "+v"(vf[1]), "+v"(vf[2]), "+v"(vf[3]), "+v"(vf[4]), "+v"(vf[5]), "+v"(vf[6]), "+v"(vf[7]));
}
DI void pv(f32x16 (&o)[2], const bf16x8 (&vf)[8], const f32x16& p0, const f32x16& p1) {
    bf16x8 pa[4];
#pragma unroll
    for (int s = 0; s < 2; ++s) {
        v4u w0, w1;
        w0.x = cvtpk(p0[8 * s], p0[8 * s + 1]); w0.y = cvtpk(p0[8 * s + 2], p0[8 * s + 3]); w0.z = cvtpk(p0[8 * s + 4], p0[8 * s + 5]); w0.w = cvtpk(p0[8 * s + 6], p0[8 * s + 7]);
        w1.x = cvtpk(p1[8 * s], p1[8 * s + 1]); w1.y = cvtpk(p1[8 * s + 2], p1[8 * s + 3]); w1.z = cvtpk(p1[8 * s + 4], p1[8 * s + 5]); w1.w = cvtpk(p1[8 * s + 6], p1[8 * s + 7]);
        pa[s] = __builtin_bit_cast(bf16x8, w0); pa[2 + s] = __builtin_bit_cast(bf16x8, w1);
    }
#pragma unroll
    for (int ks = 0; ks < 4; ++ks) { o[0] = FA_MFMA32(pa[ks], vf[ks], o[0]); o[1] = FA_MFMA32(pa[ks], vf[4 + ks], o[1]); }
}
DI float rowmax32(const f32x16& p0, const f32x16& p1) {
    float a = fmaxf(p0[0], p1[0]);
#pragma unroll
    for (int r = 1; r < 16; ++r) a = fmaxf(a, fmaxf(p0[r], p1[r]));
    return swap_max(a);
}
struct Tile { const bf16* kp; const bf16* vp; int stride; };

DI void attn_unit(const Ctx& C, int b, int g, int qt, int wslot, LAS unsigned char* lds) {
    const int lane = C.lane, wave = C.wave, r32 = lane & 31, hi = lane >> 5, qi = r32 >> 2, h = r32 & 3;
    const int ql = 8 * wave + qi, t = 64 * qt + ql, cur = qt;
    const size_t tokrow = (size_t)b * SEQ + t;
    const lds_cptr L = (lds_cptr)lds;
    LAS float* wsf = (LAS float*)(lds + L_WSF + wave * 256);
    LAS float* pw = (LAS float*)(lds + L_PW + wave * 8192); LAS float* impG = pw; LAS float* impE = pw + 8 * 65;
    LAS unsigned* selw = (LAS unsigned*)(lds + L_SEL);
#ifdef PROBE_TS
#define FA_STAMP(k) do { if (blockIdx.x == 0 && C.tid == 0 && qt == 63) ((unsigned long long*)(C.ws + 256))[k] = rt(); } while (0)
#else
#define FA_STAMP(k) do {} while (0)
#endif
    FA_STAMP(12);
#define FA_GATE(br) ({ int l_ = lane; asm volatile("" : "+v"(l_)); sigm(bf2f(C.GN()[((size_t)b * SEQ + 64 * qt + 8 * wave + ((l_ & 31) >> 2)) * 32 + (br) * 8 + g * 4 + (l_ & 3)])); })
    float wcv[3][8]; WconvItem wcI[3]; bool wcon[3];
#pragma unroll
    for (int j = 0; j < 3; ++j) { wcon[j] = wconv_decode(C, (wslot * 3 + j) * (C.G * NWAVES) + C.vcu * NWAVES + wave, lane, wcI[j]);
#pragma unroll
        for (int e = 0; e < 8; ++e) wcv[j][e] = wcon[j] ? wcI[j].src[(size_t)e * wcI[j].ldn] : 0.f; }
    const int nct = (4 * qt + 3 + 63) >> 6;
    const int nslc = cur + 1, w_lo = (qt >= 8) ? qt - 8 : 0, nwin = qt - w_lo + 1;
    const int i_b = nct, i_c = 2 * nct, i_d = i_c + nslc, ntile = i_d + nwin;
    const bf16* kcb = C.KC() + (size_t)((b * 2 + g) * 256) * 64; const bf16* vcb = C.VC() + (size_t)((b * 2 + g) * 256) * 64;
    const bf16* kvb = C.KV() + (size_t)b * SEQ * 768 + g * 64;
    const int krow = lane, kcol = 8 * wave, vrow = 16 * (wave & 3) + (lane >> 2), vcol = (wave >> 2) * 32 + (lane & 3) * 8;
    auto tile_of = [&](int i_) -> Tile {
        Tile T; const int i = (i_ < ntile) ? i_ : ntile - 1;
        if (i < i_c) { const int kt = (i < i_b) ? i : i - i_b; T.stride = 64; T.kp = kcb + (size_t)(64 * kt + krow) * 64 + kcol; T.vp = (i < i_b) ? nullptr : vcb + (size_t)(64 * kt + vrow) * 64 + vcol; }
        else if (i < i_d) { const int j = i - i_c; T.stride = 768; T.kp = kvb + (size_t)(64 * j + krow) * 768 + 256 + kcol; T.vp = kvb + (size_t)(64 * j + vrow) * 768 + 384 + vcol; }
        else { const int kt = qt - (i - i_d); T.stride = 768; T.kp = kvb + (size_t)(64 * kt + krow) * 768 + 512 + kcol; T.vp = kvb + (size_t)(64 * kt + vrow) * 768 + 640 + vcol; }
        return T;
    };
    v4u kreg, vreg = {0u, 0u, 0u, 0u};
    bool hasv = false;
    { const Tile T0 = tile_of(0); kreg = *(const v4u*)T0.kp; if (T0.vp) vreg = *(const v4u*)T0.vp; }
    *(LAS v4u*)(lds + L_K + wave * 1024 + lane * 16) = kreg; *(LAS v4u*)(lds + L_V + wave * 1024 + lane * 16) = vreg;
    int vprev = 2, vcur = 0, vnext = 1;
    const int ntile_eff = ntile + (((ntile - i_c) & 1) ? 0 : 1);
    bf16x8 qr[4];
    { const bf16* qp = C.Q() + tokrow * 512 + (g * 4 + h) * 64 + 8 * hi;
      float qv[4][8]; float ss = 0.f;
#pragma unroll
      for (int d0 = 0; d0 < 4; ++d0) { const v4u w = *(const v4u*)(qp + 16 * d0);
          qv[d0][0] = __uint_as_float(w.x << 16); qv[d0][1] = __uint_as_float(w.x & 0xffff0000u); qv[d0][2] = __uint_as_float(w.y << 16); qv[d0][3] = __uint_as_float(w.y & 0xffff0000u);
          qv[d0][4] = __uint_as_float(w.z << 16); qv[d0][5] = __uint_as_float(w.z & 0xffff0000u); qv[d0][6] = __uint_as_float(w.w << 16); qv[d0][7] = __uint_as_float(w.w & 0xffff0000u);
#pragma unroll
          for (int j = 0; j < 8; ++j) ss += qv[d0][j] * qv[d0][j]; }
      ss = swap_sum(ss);
      const float rs = rsqrtf(ss * (1.0f / 64.0f) + 1e-6f) * 0.18033688011112042f;
      const float* qw = C.q_norm_w() + 8 * hi;
#pragma unroll
      for (int d0 = 0; d0 < 4; ++d0) { const f32x4 wa = *(const f32x4*)(qw + 16 * d0), wb = *(const f32x4*)(qw + 16 * d0 + 4);
#pragma unroll
          for (int j = 0; j < 4; ++j) { qv[d0][j] *= rs * wa[j]; qv[d0][4 + j] *= rs * wb[j]; } }
      { const f32x4 c0 = *(const f32x4*)(C.ROPE_C() + t * 8), c1 = *(const f32x4*)(C.ROPE_C() + t * 8 + 4), s0 = *(const f32x4*)(C.ROPE_S() + t * 8), s1 = *(const f32x4*)(C.ROPE_S() + t * 8 + 4);
#pragma unroll
        for (int j = 0; j < 8; ++j) { const float own = qv[0][j], other = __shfl_xor(own, 32); const float c = (j < 4) ? c0[j & 3] : c1[j & 3], s = (j < 4) ? s0[j & 3] : s1[j & 3];
            qv[0][j] = hi ? own * c + other * s : own * c - other * s; } }
#pragma unroll
      for (int d0 = 0; d0 < 4; ++d0) { v4u w; w.x = cvtpk(qv[d0][0], qv[d0][1]); w.y = cvtpk(qv[d0][2], qv[d0][3]); w.z = cvtpk(qv[d0][4], qv[d0][5]); w.w = cvtpk(qv[d0][6], qv[d0][7]); qr[d0] = __builtin_bit_cast(bf16x8, w); } }
    __syncthreads();

    f32x16 o[2], p0, p1, zero16;
#pragma unroll
    for (int r = 0; r < 16; ++r) { o[0][r] = 0.f; o[1][r] = 0.f; zero16[r] = 0.f; }
    float lsum = 0.f, invl = 0.f;
    const int nvrow = (t >= 31) ? ((t - 31) >> 4) + 1 : 0;
    const int qlm = ql - 4 * hi;
    int i = 0;
#define FA_PREFETCH() const bool more = (i + 1 < ntile_eff); hasv = false; \
        if (more) { const Tile Tn = tile_of(i + 1); kreg = *(const v4u*)Tn.kp; hasv = (Tn.vp != nullptr); if (hasv) vreg = *(const v4u*)Tn.vp; } \
        const lds_cptr kslot = L + L_K + (i & 1) * 8192, vslot = L + L_V + vcur * 8192; (void)vslot
#define FA_COMMIT() do { if (more) { *(LAS v4u*)(lds + L_K + ((i + 1) & 1) * 8192 + wave * 1024 + lane * 16) = kreg; if (hasv) *(LAS v4u*)(lds + L_V + vnext * 8192 + wave * 1024 + lane * 16) = vreg; } \
        __syncthreads(); vprev = vcur; vcur = vnext; vnext = (vnext == 2) ? 0 : vnext + 1; } while (0)
    for (; i < i_b; ++i) {
        FA_PREFETCH();
        qkt(p0, p1, kslot, qr, zero16, r32, hi);
        const int nb = 64 * i + 4 * hi;
#pragma unroll
        for (int r = 0; r < 16; ++r) { const int c = (r & 3) + 8 * (r >> 2); if (nb + c >= nvrow) p0[r] = NEGF; if (nb + c + 32 >= nvrow) p1[r] = NEGF; }
        float s = 0.f;
#pragma unroll
        for (int r = 0; r < 16; ++r) s += __builtin_amdgcn_exp2f(p0[r]) + __builtin_amdgcn_exp2f(p1[r]);
        lsum += s;
        FA_COMMIT();
    }
    { const float lt = swap_sum(lsum); invl = (nvrow > 0) ? __builtin_amdgcn_rcpf(lt) : 0.f; }
    FA_STAMP(15);
    for (; i < i_c; ++i) {
        FA_PREFETCH();
        const int kt = i - i_b;
        qkt(p0, p1, kslot, qr, zero16, r32, hi);
        const int nb = 64 * kt + 4 * hi;
#pragma unroll
        for (int r = 0; r < 16; ++r) { const int c = (r & 3) + 8 * (r >> 2);
            p0[r] = (nb + c < nvrow) ? __builtin_amdgcn_exp2f(p0[r]) * invl : 0.f; p1[r] = (nb + c + 32 < nvrow) ? __builtin_amdgcn_exp2f(p1[r]) * invl : 0.f; }
        { bf16x8 vf[8]; v_load(vf, vslot, lane, hi); pv(o, vf, p0, p1); }
#pragma unroll
        for (int pp = 0; pp < 2; ++pp)
#pragma unroll
            for (int rr = 0; rr < 4; ++rr) {
                float v[4];
#pragma unroll
                for (int k = 0; k < 4; ++k) v[k] = quad_sum(pp ? p1[4 * rr + k] : p0[4 * rr + k]);
                if (h == 0) { const int m = 16 * kt + 8 * pp + 2 * rr + hi; impG[qi * 65 + m] = (v[0] + v[1]) + (v[2] + v[3]); impE[qi * 65 + m] = v[3]; }
            }
        FA_COMMIT();
    }
    FA_STAMP(16);
    { const unsigned long long lanebit = 1ull << lane;
      const unsigned long long valid = (cur == 63) ? ~0ull : ((1ull << (cur + 1)) - 1ull);
      const unsigned long long forced = 1ull | (1ull << cur) | ((cur >= 1) ? (1ull << (cur - 1)) : 0ull);
      const unsigned long long candm = valid & ~forced;
      const int ncand = (cur >= 2) ? cur - 2 : 0;
      if (ncand > 13) {
          unsigned key[8], T[8];
#pragma unroll
          for (int q8 = 0; q8 < 8; ++q8) { float imp = impG[q8 * 65 + lane]; if (lane >= 1) imp += impE[q8 * 65 + lane - 1];
              key[q8] = ((candm & lanebit) != 0ull) ? __float_as_uint(imp) : 0u; T[q8] = 0u; }
#pragma unroll 1
          for (int bit = 30; bit >= 0; --bit) {
#pragma unroll
              for (int q8 = 0; q8 < 8; ++q8) { const unsigned trial = T[q8] | (1u << bit); const unsigned long long ge = __ballot(key[q8] >= trial) & candm; if (__builtin_popcountll(ge) >= 13) T[q8] = trial; }
          }
#pragma unroll
          for (int q8 = 0; q8 < 8; ++q8) {
              const unsigned long long gt = __ballot(key[q8] > T[q8]) & candm, eq = __ballot(key[q8] == T[q8]) & candm;
              const int take = 13 - __builtin_popcountll(gt);
              const int below = __builtin_popcountll(eq & (lanebit - 1ull));
              const unsigned long long eqsel = __ballot(((eq & lanebit) != 0ull) && below < take);
              const unsigned long long sm = forced | gt | eqsel;
              if (lane == 0) { selw[2 * (8 * wave + q8)] = (unsigned)sm; selw[2 * (8 * wave + q8) + 1] = (unsigned)(sm >> 32); }
          }
      } else if (lane < 8) { selw[2 * (8 * wave + lane)] = (unsigned)valid; selw[2 * (8 * wave + lane) + 1] = (unsigned)(valid >> 32); }
      LDS_WAIT(); asm volatile("" ::: "memory");
      }
    { const float g0_ = FA_GATE(0); if (hi == 0) wsf[r32] = g0_;
      LDS_WAIT(); asm volatile("" ::: "memory");
#pragma unroll
      for (int r = 0; r < 16; ++r) { const int row = crow(r, hi); const float f = wsf[row]; pw[row * 64 + r32] = o[0][r] * f; pw[row * 64 + 32 + r32] = o[1][r] * f; o[0][r] = 0.f; o[1][r] = 0.f; }
      LDS_WAIT(); asm volatile("" ::: "memory"); }
    FA_STAMP(13);
#pragma unroll
    for (int j = 0; j < 3; ++j) if (wcon[j]) { v4u o;
        if (wcI[j].rs) { o.x = cvtpk(wcv[j][0] * wcI[j].rs[0], wcv[j][1] * wcI[j].rs[1]); o.y = cvtpk(wcv[j][2] * wcI[j].rs[2], wcv[j][3] * wcI[j].rs[3]); o.z = cvtpk(wcv[j][4] * wcI[j].rs[4], wcv[j][5] * wcI[j].rs[5]); o.w = cvtpk(wcv[j][6] * wcI[j].rs[6], wcv[j][7] * wcI[j].rs[7]); }
        else { o.x = cvtpk(wcv[j][0], wcv[j][1]); o.y = cvtpk(wcv[j][2], wcv[j][3]); o.z = cvtpk(wcv[j][4], wcv[j][5]); o.w = cvtpk(wcv[j][6], wcv[j][7]); }
        *(v4u*)wcI[j].dst = o; }
    lsum = 0.f;
    f32x16 pA0, pA1, pB0, pB1;
#define FA_SB() __builtin_amdgcn_sched_barrier(0)
#define FA_PIN(x) asm volatile("" : "+v"(x))
#define FA_MASK(C0, C1, i_) do { const bool is_slc_ = ((i_) < i_d); const int j_ = is_slc_ ? ((i_) - i_c) : (qt - ((i_) - i_d)); \
        if ((i_) >= ntile) { _Pragma("unroll") for (int r = 0; r < 16; ++r) { C0[r] = NEGF; C1[r] = NEGF; } } \
        else { if (j_ == qt) { _Pragma("unroll") for (int r = 0; r < 16; ++r) { const int c = (r & 3) + 8 * (r >> 2); if (c > qlm) C0[r] = NEGF; if (c + 32 > qlm) C1[r] = NEGF; } } \
               else if (!is_slc_ && j_ == qt - 8) { _Pragma("unroll") for (int r = 0; r < 16; ++r) { const int c = (r & 3) + 8 * (r >> 2); if (c <= qlm) C0[r] = NEGF; if (c + 32 <= qlm) C1[r] = NEGF; } } \
               if (is_slc_) { const unsigned wsel_ = selw[2 * ql + (j_ >> 5)]; if (!((wsel_ >> (j_ & 31)) & 1u)) { _Pragma("unroll") for (int r = 0; r < 16; ++r) { C0[r] = NEGF; C1[r] = NEGF; } } } } } while (0)
#define FA_FLUSH(gate_) do { const float lt_ = swap_sum(lsum); const float fac_ = (gate_) * __builtin_amdgcn_rcpf(lt_); \
        if (hi == 0) wsf[r32] = fac_; LDS_WAIT(); asm volatile("" ::: "memory"); \
        _Pragma("unroll") for (int r = 0; r < 16; ++r) { const int row = crow(r, hi); const float f_ = wsf[row]; pw[row * 64 + r32] += o[0][r] * f_; pw[row * 64 + 32 + r32] += o[1][r] * f_; o[0][r] = 0.f; o[1][r] = 0.f; } \
        LDS_WAIT(); asm volatile("" ::: "memory"); lsum = 0.f; } while (0)
#define FA_PK(P, B) cvtpk(P[B], P[(B) + 1])
#define FA_GAPA(MF, A0, A1, A2, A3, W0, W1, PW) do { MF; sacc += A0; sacc += A1; sacc += A2; sacc += A3; FA_PIN(sacc); W0; W1; FA_PIN(PW); FA_SB(); } while (0)
#define FA_GAPB(MF, X, B) do { MF; X[B] = __builtin_amdgcn_exp2f(X[B]); X[(B) + 1] = __builtin_amdgcn_exp2f(X[(B) + 1]); X[(B) + 2] = __builtin_amdgcn_exp2f(X[(B) + 2]); X[(B) + 3] = __builtin_amdgcn_exp2f(X[(B) + 3]); FA_PIN(X); FA_SB(); } while (0)
#define FA_VFR(k) (bf16x8){vlo[k][0], vlo[k][1], vlo[k][2], vlo[k][3], vhi[k][0], vhi[k][1], vhi[k][2], vhi[k][3]}
#define FA_KRD(k) kf[k] = *(const LAS bf16x8*)(kb_ + ((k) >> 1) * 2048 + ((k) & 1) * 512)
#define FA_VRD(k) do { vlo[k] = vtr(vb_ + ((k) >> 2) * 4096 + ((k) & 3) * 1024); vhi[k] = vtr(vb_ + ((k) >> 2) * 4096 + ((k) & 3) * 1024 + 512); } while (0)
#define FA_STEP(C0, C1, P0, P1) do { \
        FA_PREFETCH(); \
        const lds_cptr kb_ = kslot + hi * 1024 + r32 * 16; bf16x8 kf[8]; \
        const lds_cptr vb_ = L + L_V + vprev * 8192 + ((lane >> 4) & 1) * 32 + (lane & 3) * 8 + (4 * hi + ((lane & 15) >> 2)) * 64; s16x4 vlo[8], vhi[8]; \
        FA_KRD(0); FA_KRD(1); FA_KRD(2); FA_SB(); \
        v4u pw0, pw1, pw2, pw3; float sacc = P0[0] + P0[1]; \
        FA_KRD(3); FA_GAPA(C0 = FA_MFMA32(kf[0], qr[0], zero16), P0[2], P0[3], P0[4], P0[5],     pw0.x = FA_PK(P0, 0),  pw0.y = FA_PK(P0, 2),  pw0); \
        FA_KRD(4); FA_GAPA(C1 = FA_MFMA32(kf[1], qr[0], zero16), P0[6], P0[7], P0[8], P0[9],     pw0.z = FA_PK(P0, 4),  pw0.w = FA_PK(P0, 6),  pw0); \
        FA_KRD(5); FA_GAPA(C0 = FA_MFMA32(kf[2], qr[1], C0),     P0[10], P0[11], P0[12], P0[13], pw1.x = FA_PK(P0, 8),  pw1.y = FA_PK(P0, 10), pw1); \
        FA_KRD(6); FA_GAPA(C1 = FA_MFMA32(kf[3], qr[1], C1),     P0[14], P0[15], P1[0], P1[1],   pw1.z = FA_PK(P0, 12), pw1.w = FA_PK(P0, 14), pw1); \
        FA_KRD(7); FA_GAPA(C0 = FA_MFMA32(kf[4], qr[2], C0),     P1[2], P1[3], P1[4], P1[5],     pw2.x = FA_PK(P1, 0),  pw2.y = FA_PK(P1, 2),  pw2); \
        FA_VRD(0); FA_GAPA(C1 = FA_MFMA32(kf[5], qr[2], C1),     P1[6], P1[7], P1[8], P1[9],     pw2.z = FA_PK(P1, 4),  pw2.w = FA_PK(P1, 6),  pw2); \
        FA_VRD(4); FA_GAPA(C0 = FA_MFMA32(kf[6], qr[3], C0),     P1[10], P1[11], P1[12], P1[13], pw3.x = FA_PK(P1, 8),  pw3.y = FA_PK(P1, 10), pw3); \
        FA_VRD(1); FA_GAPA(C1 = FA_MFMA32(kf[7], qr[3], C1),     P1[14], P1[15], 0.f, 0.f,       pw3.z = FA_PK(P1, 12), pw3.w = FA_PK(P1, 14), pw3); \
        lsum += sacc; \
        FA_MASK(C0, C1, i); FA_SB(); \
        FA_VRD(5); FA_GAPB(o[0] = FA_MFMA32(__builtin_bit_cast(bf16x8, pw0), FA_VFR(0), o[0]), C0, 0); \
        FA_VRD(2); FA_GAPB(o[1] = FA_MFMA32(__builtin_bit_cast(bf16x8, pw0), FA_VFR(4), o[1]), C0, 4); \
        FA_VRD(6); FA_GAPB(o[0] = FA_MFMA32(__builtin_bit_cast(bf16x8, pw1), FA_VFR(1), o[0]), C0, 8); \
        FA_VRD(3); FA_GAPB(o[1] = FA_MFMA32(__builtin_bit_cast(bf16x8, pw1), FA_VFR(5), o[1]), C0, 12); \
        FA_VRD(7); FA_GAPB(o[0] = FA_MFMA32(__builtin_bit_cast(bf16x8, pw2), FA_VFR(2), o[0]), C1, 0); \
        FA_GAPB(o[1] = FA_MFMA32(__builtin_bit_cast(bf16x8, pw2), FA_VFR(6), o[1]), C1, 4); \
        FA_GAPB(o[0] = FA_MFMA32(__builtin_bit_cast(bf16x8, pw3), FA_VFR(3), o[0]), C1, 8); \
        FA_GAPB(o[1] = FA_MFMA32(__builtin_bit_cast(bf16x8, pw3), FA_VFR(7), o[1]), C1, 12); \
        if (i == i_d) FA_FLUSH(FA_GATE(1));        \
        FA_COMMIT(); } while (0)
    { FA_PREFETCH();
      qkt(pA0, pA1, kslot, qr, zero16, r32, hi);
      FA_MASK(pA0, pA1, i);
#pragma unroll
      for (int r = 0; r < 16; ++r) { pA0[r] = __builtin_amdgcn_exp2f(pA0[r]); pA1[r] = __builtin_amdgcn_exp2f(pA1[r]); }
      FA_COMMIT(); ++i; }
    for (; i < ntile_eff; i += 2) {
        FA_STEP(pB0, pB1, pA0, pA1);
        { ++i; FA_STEP(pA0, pA1, pB0, pB1); --i; }
    }
    { float s = 0.f;
#pragma unroll
      for (int r = 0; r < 16; ++r) s += pA0[r] + pA1[r];
      lsum += s;
      bf16x8 vf[8]; v_load(vf, L + L_V + vprev * 8192, lane, hi);
      pv(o, vf, pA0, pA1);
      FA_FLUSH(FA_GATE(2)); }
#undef FA_GATE
#undef FA_STEP
#undef FA_KRD
#undef FA_VRD
#undef FA_GAPA
#undef FA_GAPB
#undef FA_VFR
#undef FA_PK
#undef FA_MASK
#undef FA_FLUSH
#undef FA_SB
#undef FA_PIN
#undef FA_PREFETCH
#undef FA_COMMIT
    FA_STAMP(14);
    { bf16* ob = C.COMB() + (size_t)(b * 16 + (qt >> 2)) * (256 * 1536) + (size_t)(g * 4) * (256 * 64) + ((qt & 3) * 64 + 8 * wave) * 64;
      int lane_o = lane; asm volatile("" : "+v"(lane_o));
#pragma unroll
      for (int k = 0; k < 4; ++k) { const int idx = k * 64 + lane_o, row = idx >> 3, ch = idx & 7; const f32x4 va = *(const LAS f32x4*)(pw + row * 64 + ch * 8), vb = *(const LAS f32x4*)(pw + row * 64 + ch * 8 + 4);
          v4u v; v.x = cvtpk(va[0], va[1]); v.y = cvtpk(va[2], va[3]); v.z = cvtpk(vb[0], vb[1]); v.w = cvtpk(vb[2], vb[3]);
          *(v4u*)(ob + (size_t)(row & 3) * (256 * 64) + (row >> 2) * 64 + ch * 8) = v; }
      LDS_WAIT(); asm volatile("" ::: "memory"); }
    __syncthreads();
}
#undef FA_MFMA32
}
#ifndef MK_N_LAUNCHES
#define MK_N_LAUNCHES 1
#endif
constexpr int N_PHASES = 8;
#ifndef WGM_P1
#define WGM_P1 4
#endif
#ifndef WGM_P4
#define WGM_P4 4
#endif
#ifndef WGM_P5
#define WGM_P5 4
#endif
#ifndef WGM_P6
#define WGM_P6 8
#endif
#ifndef WGM_P7
#define WGM_P7 4
#endif
#ifdef PROBE_ATTN_CHECK
constexpr size_t PROBE_EXTRA = 0;
#else
constexpr size_t PROBE_EXTRA = 0;
#endif
struct Args { const float* in[24]; float* out; unsigned char* ws; int ph_lo, ph_hi, use_bar, pad; };
__global__ void __launch_bounds__(NWAVES * 64, 2) mega_fwd(Args args) {
    extern __shared__ __attribute__((aligned(16))) unsigned char lds_raw[];
    LAS unsigned char* lds = (LAS unsigned char*)lds_raw;
    Ctx C;
    C.tid = threadIdx.x; C.lane = C.tid & 63; C.wave = __builtin_amdgcn_readfirstlane(C.tid >> 6);
    C.G = gridDim.x; { const int bx = blockIdx.x; C.vcu = (C.G % 8 == 0) ? (bx % 8) * (C.G / 8) + bx / 8 : bx; }
    unsigned char* ws = args.ws;
    C.in = args.in; C.outp = args.out; C.ws = ws;

    for (int u = C.tid; u < (LDS_BYTES - LDSCTL_OFF) / 4; u += NWAVES * 64) ((LAS unsigned*)(lds + LDSCTL_OFF))[u] = 0u;
    __syncthreads();
    gu32* ctl = (gu32*)(ws + WS_CTL);
    XcdBarrier bar; bar.bar = (unsigned*)(ctl + CW_BAR); bar.x = 0; bar.st = nullptr;
    if (args.use_bar) bar = xcd_barrier_post((unsigned*)(ctl + CW_BAR), (volatile LAS unsigned*)(lds + MISC_OFF) + 8);
    const int lo = args.ph_lo, hi = args.ph_hi;
#define IN(k) (lo <= (k) && (k) < hi)
#ifdef ONLY_PHASE
#define PHASE_ON(k) ((k) == ONLY_PHASE)
#else
#define PHASE_ON(k) true
#endif
#ifdef PROBE_TS
#define STAMP(k) do { if (blockIdx.x == 0 && C.tid == 0) ((unsigned long long*)(ctl + 64))[k] = rt(); } while (0)
#else
#define STAMP(k) do {} while (0)
#endif
#ifdef PROBE_SEAM
#define SEAM(k) do { if ((k) == PROBE_SEAM && C.tid == 0) ((unsigned long long*)(ctl + 2048))[blockIdx.x] = rt(); if (IN(k) && IN((k) + 1)) xcd_barrier(bar); STAMP((k) + 1); \
        if ((k) == PROBE_SEAM && C.tid == 0) ((unsigned long long*)(ctl + 2048))[256 + blockIdx.x] = rt(); } while (0)
#else
#define SEAM(k) do { if (IN(k) && IN((k) + 1)) xcd_barrier(bar); STAMP((k) + 1); } while (0)
#endif

    STAMP(0);
#ifdef PROBE_START_SKEW
    if (C.tid == 0) ((unsigned long long*)(ctl + 2048))[blockIdx.x] = rt();
#endif
#ifdef PROBE_GAP
    if (C.tid == 0) ((unsigned long long*)(ctl + 2048))[blockIdx.x] = rt();
#endif
    if (PHASE_ON(0) && IN(0)) { p0_prologue(C, lds); }
    SEAM(0);
    if (PHASE_ON(1) && IN(1)) {
        pg8::Gemm g{C.XN(), C.WIN(), T, NPROJ, DM}; pg8::StaticOrder S; S.init(T, NPROJ, C.G, (int)blockIdx.x, 0, WGM_P1);
        pg8::EpiProj E{C.ws};
        pg8::gemm_phase<pg8::EpiProj, pg8::StaticOrder, true, true>(lds + RING_OFF, g, S, E);
    }
    SEAM(1);
    if (PHASE_ON(2) && IN(2)) {
        for (int s = C.vcu; s < 256; s += C.G) lru_strip(C, s, lds);
        STAMP(9);
        for (int it = C.vcu; it < 256; it += C.G) compress_item(C, it, lds);
        STAMP(10);
        const int gw = C.vcu * NWAVES + C.wave, NGW = C.G * NWAVES;
        (void)gw; (void)NGW;
    }
    SEAM(2);
    if (PHASE_ON(3) && IN(3)) {
#ifdef NAIVE_ATTN
        const int gw = C.vcu * NWAVES + C.wave, NGW = C.G * NWAVES;
        LAS float* wl = (LAS float*)(lds + C.wave * 8192);
        for (int q = gw; q < BATCH * 2 * SEQ; q += NGW) attn_naive(C, q, wl, C.COMB());
#else
        for (int u = C.vcu; u < 1024; u += C.G) { const int bg = (u & 255) >> 4, s = u & 15, k = u >> 8;
            const int qt = (k == 0) ? 63 - s : (k == 1) ? 32 + s : (k == 2) ? 31 - s : s;
            fa::attn_unit(C, bg >> 1, bg & 1, qt, u / C.G, lds); }
        { const int NW = C.G * NWAVES; const int done = ((1024 + C.G - 1) / C.G) * 3 * NW; WconvItem I;
          for (int idx = done + C.vcu * NWAVES + C.wave; idx < 21504; idx += NW) if (wconv_decode(C, idx, C.lane, I)) { float v[8];
#pragma unroll
              for (int e = 0; e < 8; ++e) v[e] = I.src[(size_t)e * I.ldn] * (I.rs ? I.rs[e] : 1.0f);
              v4u o; o.x = cvtpk2(v[0], v[1]); o.y = cvtpk2(v[2], v[3]); o.z = cvtpk2(v[4], v[5]); o.w = cvtpk2(v[6], v[7]); *(v4u*)I.dst = o; } }
#endif
#ifdef PROBE_ATTN_CHECK
        { const int gw = C.vcu * NWAVES + C.wave, NGW = C.G * NWAVES;
          bf16* o2 = (bf16*)(ws + WS_XR);
          LAS float* wl = (LAS float*)(lds + C.wave * 8192);
          __syncthreads();
          for (int q = gw; q < BATCH * 2 * SEQ; q += NGW) attn_naive(C, q, wl, o2);
          xcd_barrier(bar);
          float md = 0.f; int big = 0;
          for (size_t e = (size_t)(C.vcu * NWAVES * 64 + C.tid); e < (size_t)T * 512; e += (size_t)C.G * NWAVES * 64) { const size_t ee = (e >> 9) * 1536 + (e & 511); const float d = fabsf(bf2f(C.COMB()[ee]) - bf2f(o2[ee])); md = fmaxf(md, d); big += (d > 0.01f) ? 1 : 0; }
          md = wave_max(md);
          if (C.lane == 0) atomicMax((unsigned*)(ctl + 2), __float_as_uint(md));
          atomicAdd((unsigned*)(ctl + 3), (unsigned)big);
        }
#endif
    }
    SEAM(3);
    if (PHASE_ON(4) && IN(4)) {
        pg8::Gemm g{C.COMB(), C.WM(), T, DM, 1536}; pg8::StaticOrder S; S.init(T, DM, C.G, (int)blockIdx.x, 0, WGM_P4);
        pg8::EpiMerge E{C.GM(), C.MERGED()};
        pg8::gemm_phase<pg8::EpiMerge, pg8::StaticOrder, true, true>(lds + RING_OFF, g, S, E);
    }
    SEAM(4);
    if (PHASE_ON(5) && IN(5)) {
        pg8::Gemm g{C.MERGED(), C.WO(), T, DM, DM}; pg8::StaticOrder S; S.init(T, DM, C.G, (int)blockIdx.x, 0, WGM_P5);
        pg8::EpiWo E{C.x(), C.HB(), C.SS()};
        pg8::gemm_phase<pg8::EpiWo, pg8::StaticOrder, true, true>(lds + RING_OFF, g, S, E);
    }
    SEAM(5);
    if (PHASE_ON(6) && IN(6)) {
#ifdef STAGGER_P6
        if ((blockIdx.x >> 3) & STAGGER_P6_MASK) { const unsigned long long t0 = rt(); while (rt() - t0 < (unsigned long long)(STAGGER_P6)) __builtin_amdgcn_s_sleep(8); }
#endif
        pg8::Gemm g{C.HB(), C.W1(), T, DFF, DM}; pg8::StaticOrder S; S.init(T, DFF, C.G, (int)blockIdx.x, 0, WGM_P6);
        pg8::EpiFF1 E{C.SS(), C.U()};
        pg8::gemm_phase<pg8::EpiFF1, pg8::StaticOrder, true, true>(lds + RING_OFF, g, S, E);
    }
    SEAM(6);
    if (PHASE_ON(7) && IN(7)) {
        pg8::Gemm g{C.U(), C.W2(), T, DM, DFF}; pg8::StaticOrder S; S.init(T, DM, C.G, (int)blockIdx.x, 0, WGM_P7);
        pg8::EpiFF2 E{C.HB(), C.out()};
        pg8::gemm_phase<pg8::EpiFF2, pg8::StaticOrder, true, true>(lds + RING_OFF, g, S, E);
    }
#ifdef PROBE_START_SKEW
    xcd_barrier(bar);
    if (blockIdx.x == 0 && C.tid == 0) { const unsigned long long* sp = (const unsigned long long*)(ctl + 2048); unsigned long long mn = ~0ull, mx = 0ull; for (int q = 0; q < (int)gridDim.x; ++q) { const unsigned long long v = sp[q]; mn = v < mn ? v : mn; mx = v > mx ? v : mx; } C.out()[0] += (float)(mx - mn) * 0.001f; }
#endif
#ifdef PROBE_SEAM
    xcd_barrier(bar);
    if (blockIdx.x == 0 && C.tid == 0) { VM_WAIT(); const unsigned long long* sp = (const unsigned long long*)(ctl + 2048); unsigned long long amn = ~0ull, amx = 0ull, emn = ~0ull, emx = 0ull; double asum = 0.0, esum = 0.0; const int nb = (int)gridDim.x;
        for (int q = 0; q < nb; ++q) { const unsigned long long a = sp[q], e = sp[256 + q]; amn = a < amn ? a : amn; amx = a > amx ? a : amx; emn = e < emn ? e : emn; emx = e > emx ? e : emx; asum += (double)(long long)(a - sp[0]); esum += (double)(long long)(e - sp[0]); }
        const float amean = (float)(asum / nb) + (float)(long long)(sp[0] - amn), emean = (float)(esum / nb) + (float)(long long)(sp[0] - amn);
        const float v = PROBE_SEAM_STAT == 0 ? (float)(amx - amn) : PROBE_SEAM_STAT == 1 ? emean - (float)(amx - amn) : PROBE_SEAM_STAT == 2 ? (float)(amx - amn) - amean : (float)(emx - emn);
        C.out()[0] += (v * 0.01f - PROBE_OFFSET) * PROBE_SCALE; }
#endif
#ifdef PROBE_TS
    xcd_barrier(bar); STAMP(8);
    if (blockIdx.x == 0 && C.tid == 0) { VM_WAIT(); const unsigned long long* tsp = (const unsigned long long*)(ctl + 64); C.out()[0] += ((float)(tsp[PROBE_TS_TO] - tsp[PROBE_TS]) * 0.01f - PROBE_OFFSET) * PROBE_SCALE; }
#endif
#ifdef PROBE_ATTN_CHECK
    xcd_barrier(bar);
    if (blockIdx.x == 0 && C.tid == 0) { const float md = __uint_as_float(__hip_atomic_load((unsigned*)(ctl + 2), RLX_AGENT)); const unsigned big = __hip_atomic_load((unsigned*)(ctl + 3), RLX_AGENT);
        C.out()[0] += PROBE_ATTN_CHECK == 1 ? md * 1000.0f : (float)big; }
#endif
#ifdef PROBE_GAP
    if (C.tid == 0) { VM_WAIT(); ((unsigned long long*)(ctl + 2048))[256 + blockIdx.x] = rt(); }
#endif
#undef IN
#undef SEAM
}
#ifdef PROBE_GAP
__global__ void gap_first(unsigned char* ws) { if (threadIdx.x == 0) ((unsigned long long*)(ws + WS_CTL + 8192))[600] = rt(); }
__global__ void gap_last(unsigned char* ws, float* out, int nb) {
    if (threadIdx.x == 0) { const unsigned long long tD = rt(); const unsigned long long* sp = (const unsigned long long*)(ws + WS_CTL + 8192); const unsigned long long tA = sp[600];
        unsigned long long smin = ~0ull, emax = 0ull; for (int q = 0; q < nb; ++q) { smin = sp[q] < smin ? sp[q] : smin; emax = sp[256 + q] > emax ? sp[256 + q] : emax; }
        const float v = PROBE_GAP == 0 ? (float)(smin - tA) : PROBE_GAP == 1 ? (float)(tD - emax) : (float)(emax - smin);
        out[0] += (v * 0.01f - PROBE_OFFSET) * PROBE_SCALE; }
}
#endif

extern "C" void kernel_launch(void* const* d_in, const int* in_sizes, int n_in, void* d_out, int out_size, void* d_ws, size_t ws_size, hipStream_t stream) {
    static int grid = 0;
    if (grid == 0) {
        if (n_in != 24 || in_sizes[0] != T * DM || out_size != T * DM || ws_size < WS_END + PROBE_EXTRA) { fprintf(stderr, "kernel_launch: unexpected shapes (n_in %d, in0 %d, out %d, ws %zu); nothing launched\n", n_in, n_in > 0 ? in_sizes[0] : -1, out_size, ws_size); grid = -1; return; }
        int dev = 0, cus = 0, per_cu = 0;
        if (hipGetDevice(&dev) != hipSuccess || hipDeviceGetAttribute(&cus, hipDeviceAttributeMultiprocessorCount, dev) != hipSuccess) { fprintf(stderr, "kernel_launch: device query failed\n"); grid = -1; return; }
        if (hipFuncSetAttribute((const void*)mega_fwd, hipFuncAttributeMaxDynamicSharedMemorySize, LDS_BYTES) != hipSuccess) { fprintf(stderr, "kernel_launch: hipFuncSetAttribute failed\n"); grid = -1; return; }
        if (hipOccupancyMaxActiveBlocksPerMultiprocessor(&per_cu, (const void*)mega_fwd, NWAVES * 64, LDS_BYTES) != hipSuccess || per_cu < 1) { fprintf(stderr, "kernel_launch: occupancy query says %d blocks per CU\n", per_cu); (void)hipGetLastError(); per_cu = 1; }
        grid = cus;
    }
    if (grid < 0) return;
    if (hipMemsetAsync((char*)d_ws + WS_CTL, 0, CTL_ZERO_BYTES, stream) != hipSuccess) { fprintf(stderr, "kernel_launch: memset failed\n"); return; }
#ifdef PROBE_GAP
    hipLaunchKernelGGL(gap_first, dim3(1), dim3(64), 0, stream, (unsigned char*)d_ws);
#endif
    Args a{};
    for (int i = 0; i < 24; ++i) a.in[i] = (const float*)d_in[i];
    a.out = (float*)d_out; a.ws = (unsigned char*)d_ws;
#if MK_N_LAUNCHES == 1
    a.ph_lo = 0; a.ph_hi = N_PHASES; a.use_bar = 1;
    void* params[] = {&a};
#ifdef PROBE_PLAIN_LAUNCH
    hipLaunchKernelGGL(mega_fwd, dim3(grid), dim3(NWAVES * 64), LDS_BYTES, stream, a); hipError_t e = hipPeekAtLastError(); (void)params;
#else
    hipError_t e = hipLaunchCooperativeKernel((const void*)mega_fwd, dim3(grid), dim3(NWAVES * 64), params, LDS_BYTES, stream);
#endif
    if (e != hipSuccess) fprintf(stderr, "kernel_launch: cooperative launch failed: %s (grid %d)\n", hipGetErrorString(e), grid);
#ifdef PROBE_GAP
    hipLaunchKernelGGL(gap_last, dim3(1), dim3(64), 0, stream, (unsigned char*)d_ws, (float*)d_out, grid);
#endif
#else
    for (int p = 0; p < N_PHASES; ++p) {
        a.ph_lo = p; a.ph_hi = p + 1; a.use_bar = 0;
        hipLaunchKernelGGL(mega_fwd, dim3(grid), dim3(NWAVES * 64), LDS_BYTES, stream, a);
    }
#endif
}
```

```cpp
#include <hip/hip_runtime.h>
#include <cstdio>
#include <cstdint>
#define MK_N_LAUNCHES 1
#define DI __device__ __forceinline__
constexpr int NWAVES = 8;
constexpr int BATCH = 8, SEQ = 4096, DM = 1024, T = BATCH * SEQ;
constexpr int NPROJ = 5632, DFF = 4096;
constexpr size_t MiB = 1u << 20;
constexpr size_t WS_CTL = 0, CTL_ZERO_BYTES = 64 * 1024;
constexpr size_t WS_SS = 256 * 1024;
constexpr size_t WS_TAB = 1 * MiB;
constexpr size_t WS_WIN = 2 * MiB, WS_WM = 13 * MiB  , WS_WO = 16 * MiB, WS_W1 = 18 * MiB, WS_W2 = 26 * MiB;
constexpr size_t WS_PK1 = 34 * MiB, WS_PV1 = 35 * MiB, WS_PK2 = 36 * MiB, WS_PV2 = 36 * MiB + 64 * 1024, WS_LWA = 36 * MiB + 128 * 1024, WS_LWX = 36 * MiB + 384 * 1024;
constexpr size_t WS_KC = 37 * MiB, WS_VC = 37 * MiB + 512 * 1024, WS_GN = 472 * MiB;
constexpr size_t WS_XN = 40 * MiB, WS_COMB = 40 * MiB  , WS_Q = 136 * MiB, WS_KV = 168 * MiB, WS_XR = 216 * MiB, WS_YR = 280 * MiB, WS_GM = 344 * MiB, WS_END = 474 * MiB;
constexpr size_t WS_HB = WS_XN, WS_MERGED = WS_XR, WS_U = WS_Q;
constexpr int CW_TMO = 0, CW_CODE = 1, CW_BAR = 4096;
constexpr int RING_OFF = 0, RING_BYTES = 131072;
constexpr int LDSCTL_OFF = RING_BYTES, MISC_OFF = LDSCTL_OFF + 320;
constexpr int LDS_BYTES = 147456;
namespace pg8 {
#define PG8_LAS __attribute__((address_space(3)))
typedef unsigned short bf16_t;
typedef short bf16x8 __attribute__((ext_vector_type(8)));
typedef float f32x4 __attribute__((ext_vector_type(4)));
typedef unsigned u32x4 __attribute__((ext_vector_type(4)));
constexpr int BM = 256, BK = 64, HALF = 128, HTB = HALF * BK * 2  , STAGE_BYTES = 8 * HTB, NXCD = 8, WGM = 8;

__host__ __device__ __forceinline__ int lds_byte(int r, int c) { const int st = (r >> 4) * 2 + (c >> 5), rr = r & 15, cc = c & 31, ob = rr * 64 + cc * 2; return st * 1024 + (ob ^ (((ob >> 9) & 1) << 5)); }
__host__ __device__ __forceinline__ void stage_rc(int b, int& R, int& C) { const int st = b / 1024, sb = b % 1024, swz = sb ^ (((sb >> 9) & 1) << 5); R = (st >> 1) * 16 + swz / 64; C = (st & 1) * 32 + (swz % 64) / 2; }
__host__ __device__ __forceinline__ int perm32(int rho) { const int n = rho >> 4, i = rho & 15; return 8 * (i >> 2) + 4 * n + (i & 3); }

struct Unit { int pm, pn; };
struct Gemm { const bf16_t* A; const bf16_t* Bt; int M, N, K; };

struct StaticOrder {
    int nM, nN, nwg, G, c, rev, wgm;
    __host__ __device__ void init(int M, int N, int G_, int c_, int rev_ = 0, int wgm_ = WGM) { nM = M / BM; nN = N / BM; nwg = nM * nN; G = G_; c = c_; rev = rev_; wgm = wgm_; }
    __host__ __device__ bool next(int i, Unit& u) const {
        const long L = (long)i * G + c; if (L >= nwg) return false;
        int wgid = (int)L; { const int q = nwg / NXCD, r = nwg % NXCD, xcd = wgid % NXCD, off = wgid / NXCD; wgid = (xcd < r ? xcd * (q + 1) : r * (q + 1) + (xcd - r) * q) + off; }
        const int nig = wgm * nN, gid = wgid / nig, fm = gid * wgm, gsz = (nM - fm) < wgm ? (nM - fm) : wgm;
        u.pm = fm + ((wgid % nig) % gsz); u.pn = (wgid % nig) / gsz; if (rev) u.pm = nM - 1 - u.pm; return true;
    }
    __device__ __forceinline__ void a_ready(const Unit&) const {}
    __device__ __forceinline__ void done(const Unit&) const {}
};

__device__ __forceinline__ unsigned cvt_pk_bf16(float lo, float hi) { unsigned r; asm volatile("v_cvt_pk_bf16_f32 %0, %1, %2" : "=v"(r) : "v"(lo), "v"(hi)); return r; }
typedef float f32x2 __attribute__((ext_vector_type(2)));
typedef unsigned u32x2 __attribute__((ext_vector_type(2)));
__device__ __forceinline__ float bf_lo(unsigned w) { return __uint_as_float(w << 16); }
__device__ __forceinline__ float bf_hi(unsigned w) { return __uint_as_float(w & 0xffff0000u); }
__device__ __forceinline__ float sigm(float x) { return __builtin_amdgcn_rcpf(1.0f + __expf(-x)); }
__device__ __forceinline__ u32x4 pack8(const f32x4 v0, const f32x4 v1) { u32x4 w; w.x = cvt_pk_bf16(v0[0], v0[1]); w.y = cvt_pk_bf16(v0[2], v0[3]); w.z = cvt_pk_bf16(v1[0], v1[1]); w.w = cvt_pk_bf16(v1[2], v1[3]); return w; }

struct EpiProj {
    static constexpr bool PERM = true, AFTER_DRAIN = false, ATILED = true, BTILED = true;     static constexpr int HOOK_T = 0;
    unsigned char* ws;
    __device__ __forceinline__ void operator()(const f32x4 (&acc)[2][2][4][2], const Unit& u, int wr, int wc, int fr, int fq) const {
        const int pn = u.pn; size_t boff; int ldc, colt;
        if (pn < 2) { boff = ::WS_Q; ldc = 512; colt = pn * 256; }
        else if (pn < 5) { boff = ::WS_KV; ldc = 768; colt = (pn - 2) * 256; }
        else if (pn < 9) { boff = ::WS_XR; ldc = 1024; colt = (pn - 5) * 256; }
        else if (pn < 13) { boff = ::WS_YR; ldc = 1024; colt = (pn - 9) * 256; }
        else if (pn < 21) { boff = ::WS_GM; ldc = 2048; colt = (pn - 13) * 256; }
        else { boff = ::WS_GN; ldc = 32; colt = 0; }
        bf16_t* base = (bf16_t*)(ws + boff);
        const int row0 = u.pm * BM + wr * 64 + fr, col0 = colt + wc * 32 + 8 * fq;
        const bool narrow = (pn == 21);
        if (narrow && wc != 0) return;
#pragma unroll
        for (int ai = 0; ai < 2; ++ai)
#pragma unroll
            for (int m = 0; m < 4; ++m) { bf16_t* rowp = base + (size_t)(row0 + ai * HALF + m * 16) * ldc + col0;
#pragma unroll
                for (int bj = 0; bj < 2; ++bj) { if (narrow && bj) continue; *(u32x4*)(rowp + bj * HALF) = pack8(acc[ai][bj][m][0], acc[ai][bj][m][1]); } }
    }
};
__device__ __forceinline__ float e2c(float x) { return __builtin_amdgcn_exp2f(__builtin_amdgcn_fmed3f(x, -43.28f, 43.28f)); }
struct EpiMerge {
    static constexpr bool PERM = true, AFTER_DRAIN = false, ATILED = true, BTILED = true; static constexpr int HOOK_T = 8;
    const bf16_t* GM; bf16_t* O;
    __device__ __forceinline__ void hook(f32x4 (&acc)[2][2][4][2], const Unit& u, int wr, int wc, int fr, int fq) const {
        const bf16_t* p = GM + (size_t)(u.pm * BM + wr * 64 + fr) * 2048 + u.pn * BM + wc * 32 + 8 * fq;
#pragma unroll
        for (int ai = 0; ai < 2; ++ai)
#pragma unroll
            for (int mh = 0; mh < 2; ++mh) {
                asm volatile("" : "+v"(p));
                u32x4 ga[2][2], gb[2][2];
#pragma unroll
                for (int mm = 0; mm < 2; ++mm)
#pragma unroll
                    for (int bj = 0; bj < 2; ++bj) { ga[mm][bj] = *(const u32x4*)(p + mm * 16 * 2048 + bj * HALF); gb[mm][bj] = *(const u32x4*)(p + mm * 16 * 2048 + 1024 + bj * HALF); }
#pragma unroll
                for (int mm = 0; mm < 2; ++mm)
#pragma unroll
                    for (int bj = 0; bj < 2; ++bj) { const int m = 2 * mh + mm; const u32x4 a = ga[mm][bj], b = gb[mm][bj];
#define PG8_RATIO(a_, b_) ((1.0f + e2c(b_)) * __builtin_amdgcn_rcpf(1.0f + e2c(a_)))
                        acc[ai][bj][m][0][0] *= PG8_RATIO(bf_lo(a.x), bf_lo(b.x)); acc[ai][bj][m][0][1] *= PG8_RATIO(bf_hi(a.x), bf_hi(b.x));
                        acc[ai][bj][m][0][2] *= PG8_RATIO(bf_lo(a.y), bf_lo(b.y)); acc[ai][bj][m][0][3] *= PG8_RATIO(bf_hi(a.y), bf_hi(b.y));
                        acc[ai][bj][m][1][0] *= PG8_RATIO(bf_lo(a.z), bf_lo(b.z)); acc[ai][bj][m][1][1] *= PG8_RATIO(bf_hi(a.z), bf_hi(b.z));
                        acc[ai][bj][m][1][2] *= PG8_RATIO(bf_lo(a.w), bf_lo(b.w)); acc[ai][bj][m][1][3] *= PG8_RATIO(bf_hi(a.w), bf_hi(b.w));
#undef PG8_RATIO
                        asm volatile("" : "+v"(acc[ai][bj][m][0]), "+v"(acc[ai][bj][m][1])); }
                asm volatile("" ::: "memory");
                p += (mh == 1 ? (HALF - 32) : 32) * 2048;
            }
    }
    __device__ __forceinline__ void operator()(const f32x4 (&acc)[2][2][4][2], const Unit& u, int wr, int wc, int fr, int fq) const {
        const int row0 = u.pm * BM + wr * 64 + fr, col0 = u.pn * BM + wc * 32 + 8 * fq;
        u32x4 gv[2][4][2];
#pragma unroll
        for (int ai = 0; ai < 2; ++ai)
#pragma unroll
            for (int m = 0; m < 4; ++m)
#pragma unroll
                for (int bj = 0; bj < 2; ++bj) gv[ai][m][bj] = *(const u32x4*)(GM + (size_t)(row0 + ai * HALF + m * 16) * 2048 + 1024 + col0 + bj * HALF);
#pragma unroll
        for (int ai = 0; ai < 2; ++ai)
#pragma unroll
            for (int m = 0; m < 4; ++m) asm volatile("" : "+v"(gv[ai][m][0]), "+v"(gv[ai][m][1]));
#pragma unroll
        for (int ai = 0; ai < 2; ++ai)
#pragma unroll
            for (int m = 0; m < 4; ++m) { const size_t row = (size_t)(row0 + ai * HALF + m * 16);
#pragma unroll
                for (int bj = 0; bj < 2; ++bj) { const int col = col0 + bj * HALF; const u32x4 g = gv[ai][m][bj];
                    f32x4 v0 = acc[ai][bj][m][0], v1 = acc[ai][bj][m][1];
#define PG8_SIG(b_) __builtin_amdgcn_rcpf(1.0f + e2c(b_))
                    v0[0] *= PG8_SIG(bf_lo(g.x)); v0[1] *= PG8_SIG(bf_hi(g.x)); v0[2] *= PG8_SIG(bf_lo(g.y)); v0[3] *= PG8_SIG(bf_hi(g.y));
                    v1[0] *= PG8_SIG(bf_lo(g.z)); v1[1] *= PG8_SIG(bf_hi(g.z)); v1[2] *= PG8_SIG(bf_lo(g.w)); v1[3] *= PG8_SIG(bf_hi(g.w));
#undef PG8_SIG
                    *(u32x4*)(O + (size_t)u.pm * (BM * 1024) + (size_t)(u.pn * 4 + bj * 2 + (wc >> 1)) * (BM * 64) + ((int)row & 255) * 64 + (wc & 1) * 32 + 8 * fq) = pack8(v0, v1); (void)col; } }
    }
};
struct EpiWo {
    static constexpr bool PERM = false, AFTER_DRAIN = false, ATILED = true, BTILED = true;     static constexpr int HOOK_T = 0;
    const float* X; bf16_t* HB; float* SS;
    __device__ __forceinline__ void operator()(const f32x4 (&acc)[2][2][4][2], const Unit& u, int wr, int wc, int fr, int fq) const {
        const int row0 = u.pm * BM + wr * 64 + fr, col0 = u.pn * BM + wc * 32 + 4 * fq;
#pragma unroll
        for (int ai = 0; ai < 2; ++ai) {
            f32x4 xv[4][2][2];
#pragma unroll
            for (int m = 0; m < 4; ++m)
#pragma unroll
                for (int bj = 0; bj < 2; ++bj)
#pragma unroll
                    for (int n = 0; n < 2; ++n) xv[m][bj][n] = *(const f32x4*)(X + (size_t)(row0 + ai * HALF + m * 16) * 1024 + col0 + bj * HALF + n * 16);
#pragma unroll
            for (int m = 0; m < 4; ++m) asm volatile("" : "+v"(xv[m][0][0]), "+v"(xv[m][0][1]), "+v"(xv[m][1][0]), "+v"(xv[m][1][1]));
#pragma unroll
            for (int m = 0; m < 4; ++m) { const int row = row0 + ai * HALF + m * 16; float ss = 0.f;
#pragma unroll
                for (int bj = 0; bj < 2; ++bj) {
                    u32x2 w[2];
#pragma unroll
                    for (int n = 0; n < 2; ++n) { const f32x4 h = xv[m][bj][n] + acc[ai][bj][m][n];
                        ss += (h[0] * h[0] + h[1] * h[1]) + (h[2] * h[2] + h[3] * h[3]);
                        w[n].x = cvt_pk_bf16(h[0], h[1]); w[n].y = cvt_pk_bf16(h[2], h[3]); }
                    const auto sx = __builtin_amdgcn_permlane16_swap(w[0].x, w[1].x, false, false), sy = __builtin_amdgcn_permlane16_swap(w[0].y, w[1].y, false, false);
                    u32x4 o; o.x = sx[0]; o.y = sy[0]; o.z = sx[1]; o.w = sy[1];
                    *(u32x4*)(HB + (size_t)u.pm * (BM * 1024) + (size_t)(u.pn * 4 + bj * 2 + (wc >> 1)) * (BM * 64) + (row & 255) * 64 + (wc & 1) * 32 + ((fq & 1) ? 12 + 4 * fq : 4 * fq)) = o; }
                { const auto s16 = __builtin_amdgcn_permlane16_swap(__float_as_uint(ss), __float_as_uint(ss), false, false); ss += __uint_as_float((fq & 1) ? s16[0] : s16[1]);
                  const auto s32 = __builtin_amdgcn_permlane32_swap(__float_as_uint(ss), __float_as_uint(ss), false, false); ss += __uint_as_float((fq & 2) ? s32[0] : s32[1]); }
                if (fq == 0) atomicAdd(SS + row, ss); }
        }
    }
};
struct EpiFF1 {
    static constexpr bool PERM = true, AFTER_DRAIN = false, ATILED = true, BTILED = true;     static constexpr int HOOK_T = 0;
    const float* SS; bf16_t* U;
    __device__ __forceinline__ void operator()(const f32x4 (&acc)[2][2][4][2], const Unit& u, int wr, int wc, int fr, int fq) const {
        const int row0 = u.pm * BM + wr * 64 + fr, col0 = u.pn * BM + wc * 32 + 8 * fq;
        float ssv[2][4];
#pragma unroll
        for (int ai = 0; ai < 2; ++ai)
#pragma unroll
            for (int m = 0; m < 4; ++m) ssv[ai][m] = SS[row0 + ai * HALF + m * 16];
        asm volatile("" : "+v"(ssv[0][0]), "+v"(ssv[0][1]), "+v"(ssv[0][2]), "+v"(ssv[0][3]), "+v"(ssv[1][0]), "+v"(ssv[1][1]), "+v"(ssv[1][2]), "+v"(ssv[1][3]));
#pragma unroll
        for (int ai = 0; ai < 2; ++ai)
#pragma unroll
            for (int m = 0; m < 4; ++m) { const int row = row0 + ai * HALF + m * 16; const float sc = rsqrtf(ssv[ai][m] * (1.0f / 1024.0f) + 1e-6f);
#pragma unroll
                for (int bj = 0; bj < 2; ++bj) { f32x4 v0 = acc[ai][bj][m][0] * sc, v1 = acc[ai][bj][m][1] * sc;
#pragma unroll
                    for (int i = 0; i < 4; ++i) { const float a = fmaxf(v0[i], 0.f), b = fmaxf(v1[i], 0.f); v0[i] = a * a; v1[i] = b * b; }
                    *(u32x4*)(U + (size_t)u.pm * (BM * 4096) + (size_t)(u.pn * 4 + bj * 2 + (wc >> 1)) * (BM * 64) + (row & 255) * 64 + (wc & 1) * 32 + 8 * fq) = pack8(v0, v1); } }
    }
};
struct EpiFF2 {
    static constexpr bool PERM = false, AFTER_DRAIN = false, ATILED = true, BTILED = true;     static constexpr int HOOK_T = 0;
    const bf16_t* HB; float* OUT;
    __device__ __forceinline__ void operator()(const f32x4 (&acc)[2][2][4][2], const Unit& u, int wr, int wc, int fr, int fq) const {
        const int row0 = u.pm * BM + wr * 64 + fr, col0 = u.pn * BM + wc * 32 + 4 * fq;
        u32x4 hq[2][4][2];
#pragma unroll
        for (int ai = 0; ai < 2; ++ai)
#pragma unroll
            for (int m = 0; m < 4; ++m)
#pragma unroll
                for (int bj = 0; bj < 2; ++bj) hq[ai][m][bj] = *(const u32x4*)(HB + (size_t)u.pm * (BM * 1024) + (size_t)(u.pn * 4 + bj * 2 + (wc >> 1)) * (BM * 64) + ((row0 + ai * HALF + m * 16) & 255) * 64 + (wc & 1) * 32 + ((fq & 1) ? 12 + 4 * fq : 4 * fq));
#pragma unroll
        for (int ai = 0; ai < 2; ++ai)
#pragma unroll
            for (int m = 0; m < 4; ++m) asm volatile("" : "+v"(hq[ai][m][0]), "+v"(hq[ai][m][1]));
        u32x2 hv[2][4][2][2];
#pragma unroll
        for (int ai = 0; ai < 2; ++ai)
#pragma unroll
            for (int m = 0; m < 4; ++m)
#pragma unroll
                for (int bj = 0; bj < 2; ++bj) { const u32x4 q = hq[ai][m][bj];
                    const auto sx = __builtin_amdgcn_permlane16_swap(q.x, q.z, false, false), sy = __builtin_amdgcn_permlane16_swap(q.y, q.w, false, false);
                    hv[ai][m][bj][0].x = sx[0]; hv[ai][m][bj][0].y = sy[0]; hv[ai][m][bj][1].x = sx[1]; hv[ai][m][bj][1].y = sy[1]; }
#pragma unroll
        for (int ai = 0; ai < 2; ++ai)
#pragma unroll
            for (int m = 0; m < 4; ++m)
#pragma unroll
                for (int bj = 0; bj < 2; ++bj)
#pragma unroll
                    for (int n = 0; n < 2; ++n) { const u32x2 w = hv[ai][m][bj][n]; f32x4 h; h[0] = bf_lo(w.x); h[1] = bf_hi(w.x); h[2] = bf_lo(w.y); h[3] = bf_hi(w.y);
                        *(f32x4*)(OUT + (size_t)(row0 + ai * HALF + m * 16) * 1024 + col0 + bj * HALF + n * 16) = h + acc[ai][bj][m][n]; }
    }
};
template <class Epi, class Sched, bool ALIGN_EPI = false, bool SP2 = false>
__device__ __forceinline__ void gemm_phase(PG8_LAS unsigned char* lds, const Gemm g, const Sched& S, const Epi& E) {
    const int tid = threadIdx.x, wid = __builtin_amdgcn_readfirstlane(tid >> 6), lane = tid & 63, wr = wid >> 2, wc = wid & 3, fr = lane & 15, fq = lane >> 4;
    const int K = g.K, nt = K / BK;
    constexpr bool AT = Epi::ATILED, BT = Epi::BTILED;
    unsigned voffA[2], voffB[2];
#pragma unroll
    for (int i = 0; i < 2; ++i) { int R, C; stage_rc(tid * 16 + i * 8192, R, C); const int Rb = Epi::PERM ? ((R & ~31) + perm32(R & 31)) : R;
        voffA[i] = (unsigned)(R * (AT ? BK : K) + C) * 2u; voffB[i] = (unsigned)(Rb * (BT ? BK : K) + C) * 2u; }
    const size_t istepR = (size_t)64 * K * 2, istepT = (size_t)64 * BK * 2, istepA = AT ? istepT : istepR, istepB = BT ? istepT : istepR;
    const size_t kstepR = (size_t)(BK * 2), kstepT = (size_t)BM * BK * 2, kstepA = AT ? kstepT : kstepR, kstepB = BT ? kstepT : kstepR;
    const size_t hstepR = (size_t)HALF * K * 2, hstepT = (size_t)HALF * BK * 2, hstepA = AT ? hstepT : hstepR, hstepB = BT ? hstepT : hstepR;
    const size_t tstep = (size_t)BM * K * 2;
    const unsigned ldsw = (unsigned)wid * 1024u;
    const int aoff = lds_byte(wr * 64 + fr, fq * 8), boff = lds_byte(wc * 32 + fr, fq * 8);
#define PG8_SA(b, h) (((b) * 2 + (h)) * HTB)
#define PG8_SB(b, h) ((4 + (b) * 2 + (h)) * HTB)
#define PG8_STAGE_(bufoff, gbase, voff, istep_) do { _Pragma("unroll") for (int _i = 0; _i < 2; ++_i) \
        __builtin_amdgcn_global_load_lds((const unsigned*)((const char*)(gbase) + (size_t)_i * (istep_) + (voff)[0]), (PG8_LAS unsigned*)(lds + (bufoff) + ldsw + _i * 8192), 16, 0, 0); } while (0)
#define PG8_STAGEA(bufoff, gbase) PG8_STAGE_(bufoff, gbase, voffA, istepA)
#define PG8_STAGEB(bufoff, gbase) PG8_STAGE_(bufoff, gbase, voffB, istepB)
#define PG8_LDA(dst, b, h) do { _Pragma("unroll") for (int m = 0; m < 4; ++m) _Pragma("unroll") for (int k = 0; k < 2; ++k) dst[m][k] = *(const PG8_LAS bf16x8*)(lds + PG8_SA(b, h) + aoff + m * 2048 + k * 1024); } while (0)
#define PG8_LDB(dst, b, h) do { _Pragma("unroll") for (int n = 0; n < 2; ++n) _Pragma("unroll") for (int k = 0; k < 2; ++k) dst[n][k] = *(const PG8_LAS bf16x8*)(lds + PG8_SB(b, h) + boff + n * 2048 + k * 1024); } while (0)
#define PG8_MMA(ai, bj, At, Bt) do { __builtin_amdgcn_s_setprio(1); _Pragma("unroll") for (int m = 0; m < 4; ++m) _Pragma("unroll") for (int n = 0; n < 2; ++n) _Pragma("unroll") for (int k = 0; k < 2; ++k) \
        acc[ai][bj][m][n] = __builtin_amdgcn_mfma_f32_16x16x32_bf16(Bt[n][k], At[m][k], acc[ai][bj][m][n], 0, 0, 0); __builtin_amdgcn_s_setprio(0); } while (0)
#define PG8_WAIT_V(n) asm volatile("s_waitcnt vmcnt(" #n ")" ::: "memory")
#define PG8_WAIT_L(n) asm volatile("s_waitcnt lgkmcnt(" #n ")" ::: "memory")
#define PG8_BAR __builtin_amdgcn_s_barrier()
#define PG8_SCHED __builtin_amdgcn_sched_barrier(0)
    Unit cur, nxt; int ui = 0;
    if (!S.next(0, cur)) return;
    f32x4 acc[2][2][4][2];
#pragma unroll
    for (int a = 0; a < 2; ++a)
#pragma unroll
        for (int b = 0; b < 2; ++b)
#pragma unroll
            for (int m = 0; m < 4; ++m)
#pragma unroll
                for (int n = 0; n < 2; ++n) acc[a][b][m][n] = (f32x4){0.f, 0.f, 0.f, 0.f};
    bf16x8 At[4][2], B0[2][2], B1[2][2];
    const char* cA = (const char*)g.A + (size_t)cur.pm * tstep; const char* cB = (const char*)g.Bt + (size_t)cur.pn * tstep;
    S.a_ready(cur);
    if constexpr (SP2) {
        PG8_STAGEB(PG8_SB(0, 0), cB); PG8_STAGEB(PG8_SB(0, 1), cB + hstepB); PG8_STAGEA(PG8_SA(0, 0), cA); PG8_STAGEA(PG8_SA(0, 1), cA + hstepA);
        if (wr == 1) PG8_BAR;
        PG8_WAIT_V(2); PG8_BAR;
        PG8_STAGEB(PG8_SB(1, 0), cB + kstepB); PG8_STAGEA(PG8_SA(1, 0), cA + kstepA); PG8_STAGEB(PG8_SB(1, 1), cB + hstepB + kstepB);
        PG8_WAIT_V(6); PG8_BAR;
    } else {
        PG8_STAGEB(PG8_SB(0, 0), cB); PG8_STAGEA(PG8_SA(0, 0), cA); PG8_STAGEB(PG8_SB(0, 1), cB + hstepB); PG8_STAGEA(PG8_SA(0, 1), cA + hstepA);
        if (wr == 1) PG8_BAR;
        PG8_WAIT_V(4); PG8_BAR;
        PG8_STAGEB(PG8_SB(1, 0), cB + kstepB); PG8_STAGEA(PG8_SA(1, 0), cA + kstepA); PG8_STAGEB(PG8_SB(1, 1), cB + hstepB + kstepB);
        PG8_WAIT_V(6); PG8_BAR;
    }
    for (;;) {
        const bool has_next = S.next(ui + 1, nxt);
        const char* nA = has_next ? (const char*)g.A + (size_t)nxt.pm * tstep : cA; const char* nB = has_next ? (const char*)g.Bt + (size_t)nxt.pn * tstep : cB;
        for (int t = 0; t < nt; t += 2) {
            const bool last = (t == nt - 2);
            const char* a1 = cA + (size_t)(t + 1) * kstepA;
            const char* a2 = last ? nA : cA + (size_t)(t + 2) * kstepA; const char* b2 = last ? nB : cB + (size_t)(t + 2) * kstepB;
            const char* a3 = a2 + kstepA; const char* b3 = b2 + kstepB;
            if (last && has_next) S.a_ready(nxt);
            if constexpr (Epi::HOOK_T > 0) { if (t == Epi::HOOK_T) E.hook(acc, cur, wr, wc, fr, fq); }
            if constexpr (SP2) {
            PG8_LDB(B0, 0, 0); PG8_LDB(B1, 0, 1); PG8_SCHED; PG8_LDA(At, 0, 0); PG8_STAGEA(PG8_SA(1, 1), a1 + hstepA);
            PG8_WAIT_V(8); PG8_WAIT_L(0); PG8_BAR; PG8_MMA(0, 0, At, B0); PG8_MMA(0, 1, At, B1); PG8_BAR; PG8_SCHED;
            PG8_LDA(At, 0, 1); PG8_STAGEB(PG8_SB(0, 0), b2); PG8_STAGEB(PG8_SB(0, 1), b2 + hstepB); PG8_STAGEA(PG8_SA(0, 0), a2);
            PG8_WAIT_V(8); PG8_WAIT_L(0); PG8_BAR; PG8_MMA(1, 0, At, B0); PG8_MMA(1, 1, At, B1); PG8_BAR; PG8_SCHED;
            PG8_LDB(B0, 1, 0); PG8_LDB(B1, 1, 1); PG8_SCHED; PG8_LDA(At, 1, 0); PG8_STAGEA(PG8_SA(0, 1), a2 + hstepA);
            PG8_WAIT_V(8); PG8_WAIT_L(0); PG8_BAR; PG8_MMA(0, 0, At, B0); PG8_MMA(0, 1, At, B1); PG8_BAR; PG8_SCHED;
            PG8_LDA(At, 1, 1); PG8_STAGEB(PG8_SB(1, 0), b3); PG8_STAGEB(PG8_SB(1, 1), b3 + hstepB); PG8_STAGEA(PG8_SA(1, 0), a3);
            PG8_WAIT_V(8); PG8_WAIT_L(0); PG8_BAR; PG8_MMA(1, 0, At, B0); PG8_MMA(1, 1, At, B1); PG8_BAR; PG8_SCHED;
            } else {
            PG8_LDB(B0, 0, 0); PG8_SCHED; PG8_LDA(At, 0, 0); PG8_STAGEA(PG8_SA(1, 1), a1 + hstepA);
            PG8_WAIT_L(8); PG8_BAR; PG8_WAIT_L(0); PG8_MMA(0, 0, At, B0); PG8_BAR; PG8_SCHED;
            PG8_LDB(B1, 0, 1); PG8_STAGEB(PG8_SB(0, 0), b2);
            PG8_BAR; PG8_WAIT_L(0); PG8_MMA(0, 1, At, B1); PG8_BAR;
            PG8_LDA(At, 0, 1); PG8_STAGEA(PG8_SA(0, 0), a2);
            PG8_BAR; PG8_WAIT_L(0); PG8_MMA(1, 0, At, B0); PG8_BAR; PG8_SCHED;
            PG8_STAGEB(PG8_SB(0, 1), b2 + hstepB);
            PG8_WAIT_V(6); PG8_BAR; PG8_MMA(1, 1, At, B1); PG8_BAR;
            PG8_LDB(B0, 1, 0); PG8_SCHED; PG8_LDA(At, 1, 0); PG8_STAGEA(PG8_SA(0, 1), a2 + hstepA);
            PG8_WAIT_L(8); PG8_BAR; PG8_WAIT_L(0); PG8_MMA(0, 0, At, B0); PG8_BAR; PG8_SCHED;
            PG8_LDB(B1, 1, 1); PG8_STAGEB(PG8_SB(1, 0), b3);
            PG8_BAR; PG8_WAIT_L(0); PG8_MMA(0, 1, At, B1); PG8_BAR;
            PG8_LDA(At, 1, 1); PG8_STAGEA(PG8_SA(1, 0), a3);
            PG8_BAR; PG8_WAIT_L(0); PG8_MMA(1, 0, At, B0); PG8_BAR; PG8_SCHED;
            PG8_STAGEB(PG8_SB(1, 1), b3 + hstepB);
            PG8_WAIT_V(6); PG8_BAR; PG8_MMA(1, 1, At, B1); PG8_BAR;
            }
        }
        if constexpr (ALIGN_EPI) { if (wr == 0) PG8_BAR; }
        if constexpr (!Epi::AFTER_DRAIN) { E(acc, cur, wr, wc, fr, fq); S.done(cur); }
        if (!has_next) break;
#pragma unroll
        for (int a = 0; a < 2; ++a)
#pragma unroll
            for (int b = 0; b < 2; ++b)
#pragma unroll
                for (int m = 0; m < 4; ++m)
#pragma unroll
                    for (int n = 0; n < 2; ++n) acc[a][b][m][n] = (f32x4){0.f, 0.f, 0.f, 0.f};
        cur = nxt; cA = nA; cB = nB; ++ui;
        if constexpr (ALIGN_EPI) { if (wr == 1) PG8_BAR; }
    }
    PG8_WAIT_V(0);
    if constexpr (!ALIGN_EPI) { if (wr == 0) PG8_BAR; }
    PG8_BAR;
    if constexpr (Epi::AFTER_DRAIN) { E.fused(acc, cur, wr, wc, fr, fq, lds, wid, lane); S.done(cur); }
#undef PG8_SA
#undef PG8_SB
#undef PG8_STAGE_
#undef PG8_STAGEA
#undef PG8_STAGEB
#undef PG8_LDA
#undef PG8_LDB
#undef PG8_MMA
#undef PG8_WAIT_V
#undef PG8_WAIT_L
#undef PG8_BAR
#undef PG8_SCHED
}
}
#define GAS __attribute__((address_space(1)))
#define LAS __attribute__((address_space(3)))
typedef unsigned short bf16;
typedef unsigned v4u __attribute__((ext_vector_type(4)));
typedef float f32x4 __attribute__((ext_vector_type(4)));
typedef short bf16x8 __attribute__((ext_vector_type(8)));
typedef GAS unsigned gu32;
typedef GAS unsigned long long gu64;
#define RLX_AGENT __ATOMIC_RELAXED, __HIP_MEMORY_SCOPE_AGENT
#define LDS_WAIT() asm volatile("s_waitcnt lgkmcnt(0)" ::: "memory")
#define VM_WAIT() asm volatile("s_waitcnt vmcnt(0)" ::: "memory")
__device__ __forceinline__ unsigned long long rt() { return __builtin_amdgcn_s_memrealtime(); }
__device__ __forceinline__ unsigned f2bf(float f) { unsigned u = __builtin_bit_cast(unsigned, f); return (u + 0x7fffu + ((u >> 16) & 1u)) >> 16; }
__device__ __forceinline__ unsigned pk2(float lo, float hi) { return f2bf(lo) | (f2bf(hi) << 16); }
#define XB_TMO      128
#define XB_XCNT(j)  (256  + 64 * (j))
#define XB_XSUB(j)  (1280 + 64 * (j))
#define XB_XGEN(j)  (2304 + 64 * (j))
#define XB_TOP      3328
#define XB_TOPGEN   3392
#define XCD_BAR_WORDS 3456
#define XB_SPIN_CAP (1u << 18)

__device__ __forceinline__ unsigned xb_ld(unsigned* p)              { return __hip_atomic_load(p, __ATOMIC_RELAXED, __HIP_MEMORY_SCOPE_AGENT); }
__device__ __forceinline__ unsigned xb_add(unsigned* p, unsigned v) { return __hip_atomic_fetch_add(p, v, __ATOMIC_RELAXED, __HIP_MEMORY_SCOPE_AGENT); }
__device__ __forceinline__ unsigned xb_xcc_id() { return (unsigned)__builtin_amdgcn_s_getreg((3 << 11) | 20) & 0xFu; }
#define XB_SPIN(cond, bar) do { unsigned _sp = 0; while (cond) { __builtin_amdgcn_s_sleep(1); \
    if ((++_sp & 255u) == 0u) { if (xb_ld(&(bar)[XB_TMO])) break; if (_sp > XB_SPIN_CAP) { atomicAdd(&(bar)[XB_TMO], 1u); break; } } } } while (0)

struct XcdBarrier {
    unsigned* bar; unsigned x;
    volatile LAS unsigned* st;
};

__device__ __forceinline__ XcdBarrier xcd_barrier_post(unsigned* bar, volatile LAS unsigned* st) {
    XcdBarrier b; b.bar = bar; b.x = xb_xcc_id(); b.st = st;
    if (threadIdx.x == 0) (void)xb_add(&bar[XB_XCNT(b.x)], 1u);
    return b;
}
__device__ __forceinline__ void xcd_barrier_complete(unsigned* bar, unsigned x, unsigned& nloc, unsigned& nx) {
    const unsigned G = gridDim.x * gridDim.y * gridDim.z;
    unsigned sum, cnt, mine, sp = 0u;
    for (;;) {
        sum = 0u; cnt = 0u; mine = 0u;
#pragma unroll
        for (unsigned j = 0; j < 16; ++j) { const unsigned c = xb_ld(&bar[XB_XCNT(j)]); sum += c; cnt += (c > 0u) ? 1u : 0u; mine = (j == x) ? c : mine; }
        if (sum == G) break;
        __builtin_amdgcn_s_sleep(1);
        if ((++sp & 255u) == 0u) { if (xb_ld(&bar[XB_TMO])) break; if (sp > XB_SPIN_CAP) { atomicAdd(&bar[XB_TMO], 1u); break; } }
    }
    nloc = mine > 0u ? mine : 1u; nx = cnt > 0u ? cnt : 1u;
}

__device__ __forceinline__ void xcd_barrier(const XcdBarrier& b) {
    asm volatile("s_waitcnt vmcnt(0)" ::: "memory");
    __syncthreads();
    if (threadIdx.x == 0) {
        unsigned* bar = b.bar;
        __builtin_amdgcn_s_waitcnt(0);
        unsigned nloc = b.st[0], nx = b.st[1];
        if (nloc == 0u) { xcd_barrier_complete(bar, b.x, nloc, nx); b.st[0] = nloc; b.st[1] = nx; }
        const unsigned old = xb_add(&bar[XB_XSUB(b.x)], 1u);
        const unsigned gen = old / nloc;
        if (old + 1u == (gen + 1u) * nloc) {
            __builtin_amdgcn_fence(__ATOMIC_RELEASE, "agent");
            asm volatile("s_waitcnt vmcnt(0)" ::: "memory");
            const unsigned og = xb_add(&bar[XB_TOP], 1u);
            const unsigned tg = og / nx;
            if (og + 1u == (tg + 1u) * nx) xb_add(&bar[XB_TOPGEN], 1u);
            else XB_SPIN(xb_ld(&bar[XB_TOPGEN]) == tg, bar);
            __builtin_amdgcn_fence(__ATOMIC_ACQUIRE, "agent");
            xb_add(&bar[XB_XGEN(b.x)], 1u);
            asm volatile("s_waitcnt vmcnt(0)" ::: "memory");
        } else {
            XB_SPIN(xb_ld(&bar[XB_XGEN(b.x)]) == gen, bar);
            __builtin_amdgcn_fence(__ATOMIC_ACQUIRE, "agent");
            asm volatile("s_waitcnt vmcnt(0)" ::: "memory");
        }
    }
    __syncthreads();
}
typedef float f32x16 __attribute__((ext_vector_type(16)));
struct Ctx {
    const float* const* in; float* outp; unsigned char* ws;
    int tid, lane, wave, vcu, G;
    DI const float* x() const { return in[0]; }
    DI const float* norm1_w() const { return in[1]; }
    DI const float* w_in() const { return in[2]; }
    DI const float* q_norm_w() const { return in[3]; }
    DI const float* k_norm_w() const { return in[4]; }
    DI const float* phi_k_pos() const { return in[5]; }
    DI const float* phi_k_w1() const { return in[6]; }
    DI const float* phi_k_w2() const { return in[7]; }
    DI const float* phi_v_pos() const { return in[8]; }
    DI const float* phi_v_w1() const { return in[9]; }
    DI const float* phi_v_w2() const { return in[10]; }
    DI const float* conv_w() const { return in[11]; }
    DI const float* conv_b() const { return in[12]; }
    DI const float* lru_wa() const { return in[13]; }
    DI const float* lru_ba() const { return in[14]; }
    DI const float* lru_wx() const { return in[15]; }
    DI const float* lru_bx() const { return in[16]; }
    DI const float* lru_lambda() const { return in[17]; }
    DI const float* w_nsa_up() const { return in[18]; }
    DI const float* w_lru_up() const { return in[19]; }
    DI const float* w_o() const { return in[20]; }
    DI const float* norm2_w() const { return in[21]; }
    DI const float* w_ff1() const { return in[22]; }
    DI const float* w_ff2() const { return in[23]; }
    DI float* out() const { return outp; }
    DI float* SS() const { return (float*)(ws + WS_SS); }
    DI float* ROPE_C() const { return (float*)(ws + WS_TAB); }
    DI float* ROPE_S() const { return (float*)(ws + WS_TAB + 128 * 1024); }
    DI float* CLAM() const { return (float*)(ws + WS_TAB + 256 * 1024); }
    DI float* PHIB() const { return (float*)(ws + WS_TAB + 260 * 1024); }
    DI bf16* WIN() const { return (bf16*)(ws + WS_WIN); }
    DI bf16* WM() const { return (bf16*)(ws + WS_WM); }
    DI bf16* WO() const { return (bf16*)(ws + WS_WO); }
    DI bf16* W1() const { return (bf16*)(ws + WS_W1); }
    DI bf16* W2() const { return (bf16*)(ws + WS_W2); }
    DI bf16* PK1() const { return (bf16*)(ws + WS_PK1); }
    DI bf16* PV1() const { return (bf16*)(ws + WS_PV1); }
    DI bf16* PK2() const { return (bf16*)(ws + WS_PK2); }
    DI bf16* PV2() const { return (bf16*)(ws + WS_PV2); }
    DI bf16* LWA() const { return (bf16*)(ws + WS_LWA); }
    DI bf16* LWX() const { return (bf16*)(ws + WS_LWX); }
    DI bf16* KC() const { return (bf16*)(ws + WS_KC); }
    DI bf16* VC() const { return (bf16*)(ws + WS_VC); }
    DI bf16* GN() const { return (bf16*)(ws + WS_GN); }
    DI bf16* XN() const { return (bf16*)(ws + WS_XN); }
    DI bf16* Q() const { return (bf16*)(ws + WS_Q); }
    DI bf16* KV() const { return (bf16*)(ws + WS_KV); }
    DI bf16* XR() const { return (bf16*)(ws + WS_XR); }
    DI bf16* YR() const { return (bf16*)(ws + WS_YR); }
    DI bf16* GM() const { return (bf16*)(ws + WS_GM); }
    DI bf16* COMB() const { return (bf16*)(ws + WS_COMB); }
    DI bf16* HB() const { return (bf16*)(ws + WS_HB); }
    DI bf16* MERGED() const { return (bf16*)(ws + WS_MERGED); }
    DI bf16* U() const { return (bf16*)(ws + WS_U); }
};
DI float bf2f(bf16 h) { return __uint_as_float((unsigned)h << 16); }
typedef float f32x2_g __attribute__((ext_vector_type(2))); typedef __bf16 bf16x2_g __attribute__((ext_vector_type(2)));
DI unsigned cvtpk2(float lo, float hi) { f32x2_g v = {lo, hi}; bf16x2_g b = __builtin_convertvector(v, bf16x2_g); return __builtin_bit_cast(unsigned, b); }
DI float wave_sum(float v) {
#pragma unroll
    for (int o = 1; o < 64; o <<= 1) v += __shfl_xor(v, o);
    return v;
}
DI float wave_max(float v) {
#pragma unroll
    for (int o = 1; o < 64; o <<= 1) v = fmaxf(v, __shfl_xor(v, o));
    return v;
}
DI float sigm(float x) { return __builtin_amdgcn_rcpf(1.0f + __expf(-x)); }
DI float gelu_tanh(float x) { return x * __builtin_amdgcn_rcpf(1.0f + __builtin_amdgcn_exp2f(x * (-2.3022082f - 0.10294325f * x * x))); }
#define MFMA16(a, b, c) __builtin_amdgcn_mfma_f32_16x16x32_bf16((a), (b), (c), 0, 0, 0)

struct ColMapId { DI int operator()(int n) const { return n; } };
struct ColMapIn { DI int operator()(int n) const { return n < 1280 ? n : (n < 5376 ? n + 24 : (n < 5400 ? n - 4096 : -1)); } };
template <class CM> DI void transpose_item(const float* W, int ldsrc, const float* rowscale, bf16* WT, int K, int kb, int nb, CM cm, LAS float* scr, int lane, float gscale = 1.0f, bool tiled = false) {
    const int k0 = 64 * kb, n0 = 32 * nb; const int c = cm(n0 + (lane & 31));
    float v[32];
#pragma unroll
    for (int i = 0; i < 32; ++i) { const int kk = 2 * i + (lane >> 5); v[i] = (c >= 0) ? W[(size_t)(k0 + kk) * ldsrc + c] : 0.f; }
    asm volatile("" ::: "memory");
#pragma unroll
    for (int i = 0; i < 32; ++i) { const int kk = 2 * i + (lane >> 5); float x = v[i] * gscale; if (rowscale) x *= rowscale[k0 + kk]; scr[kk * 33 + (lane & 31)] = x; }
    LDS_WAIT(); asm volatile("" ::: "memory");
    const int cc = lane & 7;
#pragma unroll
    for (int j = 0; j < 4; ++j) { const int n = (lane >> 3) + 8 * j; const LAS float* s = scr + (8 * cc) * 33 + n;
        v4u o; o.x = pk2(s[0 * 33], s[1 * 33]); o.y = pk2(s[2 * 33], s[3 * 33]); o.z = pk2(s[4 * 33], s[5 * 33]); o.w = pk2(s[6 * 33], s[7 * 33]);
        const int nn = n0 + n, kk8 = k0 + 8 * cc;
        *(GAS v4u*)(WT + (tiled ? (size_t)(nn >> 8) * (256 * K) + (size_t)(kk8 >> 6) * (256 * 64) + (nn & 255) * 64 + (kk8 & 63) : (size_t)nn * K + kk8)) = o; }
    LDS_WAIT(); asm volatile("" ::: "memory");
}
DI void sincos_acc(double x, float& s_out, float& c_out) {
    const double TWO_PI = 6.283185307179586476925286766559, INV_2PI = 0.15915494309189533576888376337251, PI = 3.1415926535897932384626433832795;
    const double k = rint(x * INV_2PI); double r = x - k * TWO_PI; double csign = 1.0;
    if (r > 0.5 * PI) { r = PI - r; csign = -1.0; } else if (r < -0.5 * PI) { r = -PI - r; csign = -1.0; }
    const double z = r * r;
    double sp = -1.0 / 121645100408832000.0;
    sp = sp * z + 1.0 / 355687428096000.0; sp = sp * z - 1.0 / 1307674368000.0; sp = sp * z + 1.0 / 6227020800.0; sp = sp * z - 1.0 / 39916800.0;
    sp = sp * z + 1.0 / 362880.0; sp = sp * z - 1.0 / 5040.0; sp = sp * z + 1.0 / 120.0; sp = sp * z - 1.0 / 6.0; sp = sp * z + 1.0;
    double cp = 1.0 / 2432902008176640000.0;
    cp = cp * z - 1.0 / 6402373705728000.0; cp = cp * z + 1.0 / 20922789888000.0; cp = cp * z - 1.0 / 87178291200.0; cp = cp * z + 1.0 / 479001600.0;
    cp = cp * z - 1.0 / 3628800.0; cp = cp * z + 1.0 / 40320.0; cp = cp * z - 1.0 / 720.0; cp = cp * z + 1.0 / 24.0; cp = cp * z - 0.5; cp = cp * z + 1.0;
    s_out = (float)(sp * r); c_out = (float)(csign * cp);
}
DI void p0_prologue(const Ctx& C, LAS unsigned char* lds) {
    LAS float* scr = (LAS float*)(lds + C.wave * 16384);
    const int gw = C.vcu * NWAVES + C.wave, NGW = C.G * NWAVES, lane = C.lane;
    constexpr int I_IN = 16 * 176, I_NU = 8 * 32, I_LU = 16 * 32, I_WO = 16 * 32, I_W1 = 16 * 128, I_W2 = 64 * 32, I_P1 = 32 * 8, I_P2 = 4 * 2, I_LW = 8 * 8;
    constexpr int NITEMS = I_IN + 2 * I_P1 + 2 * I_P2 + 2 * I_LW;
    for (int it = gw; it < NITEMS; it += NGW) {
        int r = it;
        if (r < I_IN) { const int nb_ = r % 176; transpose_item(C.w_in(), 5400, nullptr, C.WIN(), 1024, r / 176, nb_, ColMapIn(), scr, lane, (nb_ >= 104 && nb_ < 168) ? -1.4426950408889634f : 1.0f, true); continue; } r -= I_IN;
        if (r < 2 * I_P1) {
            const int kv = r / I_P1, q = r % I_P1; const float* w1 = kv ? C.phi_v_w1() : C.phi_k_w1(); bf16* dst = kv ? C.PV1() : C.PK1();
#pragma unroll
            for (int f4 = 0; f4 < 4; ++f4) { const int fi = q * 4 + f4, ks = fi >> 4, nt = fi & 15; const float* src = w1 + (size_t)(32 * ks + 8 * (lane >> 4)) * 256 + 16 * nt + (lane & 15);
                v4u o; o.x = pk2(src[0], src[256]); o.y = pk2(src[512], src[768]); o.z = pk2(src[1024], src[1280]); o.w = pk2(src[1536], src[1792]);
                *(v4u*)(dst + ((size_t)fi * 64 + lane) * 8) = o; }
            continue; } r -= 2 * I_P1;
        if (r < I_P2) { transpose_item(C.phi_k_w2(), 64, nullptr, C.PK2(), 256, r / 2, r % 2, ColMapId(), scr, lane); continue; } r -= I_P2;
        if (r < I_P2) { transpose_item(C.phi_v_w2(), 64, nullptr, C.PV2(), 256, r / 2, r % 2, ColMapId(), scr, lane); continue; } r -= I_P2;
        if (r < I_LW) { const int n = r >> 3, q = r & 7; transpose_item(C.lru_wa() + (size_t)n * 16384, 128, nullptr, C.LWA() + (size_t)n * 16384, 128, q >> 2, q & 3, ColMapId(), scr, lane, -1.4426950408889634f); continue; } r -= I_LW;
        { const int n = r >> 3, q = r & 7; transpose_item(C.lru_wx() + (size_t)n * 16384, 128, nullptr, C.LWX() + (size_t)n * 16384, 128, q >> 2, q & 3, ColMapId(), scr, lane, -1.4426950408889634f); }
    }
    {
        f32x4 wv[4];
#pragma unroll
        for (int j = 0; j < 4; ++j) wv[j] = ((const GAS f32x4*)C.norm1_w())[lane + 64 * j];
        f32x4 v[2][4], vn[2][4];
#pragma unroll
        for (int rr = 0; rr < 2; ++rr) { const int m0 = (gw + rr * NGW < T) ? gw + rr * NGW : gw;
#pragma unroll
            for (int j = 0; j < 4; ++j) v[rr][j] = ((const GAS f32x4*)(C.x() + (size_t)m0 * DM) + lane)[64 * j]; }
        for (int m = gw; m < T; m += 2 * NGW) {
#pragma unroll
            for (int rr = 0; rr < 2; ++rr) { const int mn = (m + (2 + rr) * NGW < T) ? m + (2 + rr) * NGW : m;
#pragma unroll
                for (int j = 0; j < 4; ++j) vn[rr][j] = ((const GAS f32x4*)(C.x() + (size_t)mn * DM) + lane)[64 * j]; }
#pragma unroll
            for (int rr = 0; rr < 2; ++rr) { const int mr = m + rr * NGW;
                if (mr < T) {
                    float s = 0.f;
#pragma unroll
                    for (int j = 0; j < 4; ++j) s += (v[rr][j].x * v[rr][j].x + v[rr][j].y * v[rr][j].y) + (v[rr][j].z * v[rr][j].z + v[rr][j].w * v[rr][j].w);
                    const float rstd = rsqrtf(wave_sum(s) * (1.0f / DM) + 1e-6f);
                    GAS unsigned long long* o8 = (GAS unsigned long long*)(C.XN() + (size_t)(mr >> 8) * (256 * DM) + (size_t)(lane >> 4) * (256 * 64) + (mr & 255) * 64 + (lane & 15) * 4);
#pragma unroll
                    for (int j = 0; j < 4; ++j) o8[(size_t)j * (4 * 256 * 64 / 4)] = (unsigned long long)cvtpk2(v[rr][j].x * rstd * wv[j].x, v[rr][j].y * rstd * wv[j].y) | ((unsigned long long)cvtpk2(v[rr][j].z * rstd * wv[j].z, v[rr][j].w * rstd * wv[j].w) << 32);
                } }
#pragma unroll
            for (int rr = 0; rr < 2; ++rr)
#pragma unroll
                for (int j = 0; j < 4; ++j) v[rr][j] = vn[rr][j];
        }
    }
    {
        const int gt = C.vcu * (NWAVES * 64) + C.tid, NGT = C.G * NWAVES * 64;
        for (int e = gt; e < T; e += NGT) C.SS()[e] = 0.f;
        for (int e = C.tid * C.G + C.vcu; e < 4096 * 8 + 1024; e += NGT) {
            if (e < 4096 * 8) {
                const int pos = e >> 3, i = e & 7;
                const unsigned invb[8] = {0x3f800000u, 0x3e4693afu, 0x3d1a08c8u, 0x3beef74eu, 0x3ab95d22u, 0x398fc8f8u, 0x385f10c5u, 0x372d07a8u};
                unsigned ib = invb[0];
#pragma unroll
                for (int q = 1; q < 8; ++q) ib = (i == q) ? invb[q] : ib;
                const float ang = (float)pos * __uint_as_float(ib);
                float s, c; sincos_acc((double)ang, s, c); C.ROPE_S()[e] = s; C.ROPE_C()[e] = c;
            } else {
                const int ch = e - 4096 * 8; const float lam = C.lru_lambda()[ch]; const float xx = __expf(-lam);
                const float sp = (xx < 0.03f) ? xx * (1.0f - xx * (0.5f - xx * (0.33333333f - 0.25f * xx))) : __logf(1.0f + xx);
                C.CLAM()[ch] = -8.0f * sp * 1.4426950408889634f;
            }
        }
    }
    for (int o = C.wave * C.G + C.vcu; o < 512; o += NGW) {
        const int kv = o >> 8, n = o & 255; const float* pos = kv ? C.phi_v_pos() : C.phi_k_pos(); const float* w1 = kv ? C.phi_v_w1() : C.phi_k_w1();
        float pa[32], wa[32];
#pragma unroll
        for (int i = 0; i < 32; ++i) { const int k = lane + 64 * i; pa[i] = pos[k]; wa[i] = w1[(size_t)k * 256 + n]; }
        float s = 0.f;
#pragma unroll
        for (int i = 0; i < 32; ++i) s += pa[i] * wa[i];
        s = wave_sum(s);
        if (lane == 0) C.PHIB()[o] = s;
    }
}

#define DPPF(x, ctrl) __int_as_float(__builtin_amdgcn_update_dpp(0, __float_as_int(x), (ctrl), 0xF, 0xF, true))
struct NrTab { f32x4 nwa, nwb, ca, cb, sa, sb; };
DI void normrope8_prep(NrTab& Tb, const float* nw, const Ctx& C, int pos, int sub) {
    Tb.nwa = *(const f32x4*)(nw + sub * 8); Tb.nwb = *(const f32x4*)(nw + sub * 8 + 4);
    Tb.ca = *(const f32x4*)(C.ROPE_C() + pos * 8); Tb.cb = *(const f32x4*)(C.ROPE_C() + pos * 8 + 4);
    Tb.sa = *(const f32x4*)(C.ROPE_S() + pos * 8); Tb.sb = *(const f32x4*)(C.ROPE_S() + pos * 8 + 4);
}
DI void normrope8_apply(v4u& w, const NrTab& Tb, int sub, float scale) {
    float v[8] = {__uint_as_float(w.x << 16), __uint_as_float(w.x & 0xffff0000u), __uint_as_float(w.y << 16), __uint_as_float(w.y & 0xffff0000u),
                  __uint_as_float(w.z << 16), __uint_as_float(w.z & 0xffff0000u), __uint_as_float(w.w << 16), __uint_as_float(w.w & 0xffff0000u)};
    float ss = 0.f;
#pragma unroll
    for (int j = 0; j < 8; ++j) ss += v[j] * v[j];
    ss += DPPF(ss, 0xB1); ss += DPPF(ss, 0x4E); ss += DPPF(ss, 0x141);
    const float rstd = rsqrtf(ss * (1.0f / 64.0f) + 1e-6f);
#pragma unroll
    for (int j = 0; j < 8; ++j) v[j] = v[j] * rstd * ((j < 4) ? Tb.nwa[j & 3] : Tb.nwb[j & 3]);
#pragma unroll
    for (int j = 0; j < 8; ++j) { const float other = DPPF(v[j], 0xB1); const float c = (j < 4) ? Tb.ca[j & 3] : Tb.cb[j & 3], sn = (j < 4) ? Tb.sa[j & 3] : Tb.sb[j & 3];
        if (sub < 2) v[j] = (sub == 0) ? v[j] * c - other * sn : v[j] * c + other * sn; }
#pragma unroll
    for (int j = 0; j < 8; ++j) v[j] *= scale;
    w.x = cvtpk2(v[0], v[1]); w.y = cvtpk2(v[2], v[3]); w.z = cvtpk2(v[4], v[5]); w.w = cvtpk2(v[6], v[7]);
}
DI void normrope8(v4u& w, const float* nw, const Ctx& C, int pos, int sub, float scale) { NrTab Tb; normrope8_prep(Tb, nw, C, pos, sub); normrope8_apply(w, Tb, sub, scale); }
DI void normrope_pair(const Ctx& C, int pair) {
    const int lane = C.lane, sub = lane & 7;
    const int row = 2 * pair + (lane >> 5), vec = (lane >> 3) & 3;
    v4u* p = (v4u*)(C.KV() + (size_t)row * 768 + ((vec < 2) ? 256 : 512) + (vec & 1) * 64 + sub * 8); v4u w = *p;
    normrope8(w, C.k_norm_w() + ((vec < 2) ? 64 : 128), C, row & (SEQ - 1), sub, 1.0f); *p = w;
}

struct WconvItem { const float* src; const float* rs; bf16* dst; int ldn; };
DI bool wconv_decode(const Ctx& C, int idx, int lane, WconvItem& I) {
    int r = idx; const float* W; bf16* D; int N, pitch, coff = 0; const float* rsc = nullptr;
    if (r < 1024) { W = C.w_nsa_up(); D = C.WM(); N = 1024; pitch = 1536; }
    else if ((r -= 1024) < 2048) { W = C.w_lru_up(); D = C.WM(); N = 1024; pitch = 1536; coff = 512; }
    else if ((r -= 2048) < 2048) { W = C.w_o(); D = C.WO(); N = 1024; pitch = 1024; }
    else if ((r -= 2048) < 8192) { W = C.w_ff1(); D = C.W1(); N = 4096; pitch = 1024; rsc = C.norm2_w(); }
    else if ((r -= 8192) < 8192) { W = C.w_ff2(); D = C.W2(); N = 1024; pitch = 4096; }
    else return false;
    const int nb = N / 64, kb = r / nb, n = (r % nb) * 64 + lane, k0 = 8 * kb;
    I.src = W + (size_t)k0 * N + n; I.rs = rsc ? rsc + k0 : nullptr; I.ldn = N;
    I.dst = D + (size_t)(n >> 8) * (256 * pitch) + (size_t)((coff + k0) >> 6) * (256 * 64) + (n & 255) * 64 + ((coff + k0) & 63);
    return true;
}
constexpr int LRU_XROW = 272, LRU_WREG = 35 * 272 + 2048 + 2048;
DI void lru_strip(const Ctx& C, int strip, LAS unsigned char* lds) {
    const int tid = C.tid, lane = C.lane, wave = C.wave, l15 = lane & 15, lg = lane >> 4;
    const int b = strip >> 5, n = (strip >> 2) & 7, eq = strip & 3;
    LAS float* xch = (LAS float*)lds;
    LAS bf16x8* wf = (LAS bf16x8*)(lds + 4096);
    LAS unsigned char* XW = lds + 4096 + 16384 + wave * LRU_WREG;
    LAS unsigned char* YW = XW + 35 * LRU_XROW;
    LAS unsigned char* OW = YW + 2048;
    LAS float* cw = (LAS float*)(lds + 4096 + 16384);
    for (int i = tid; i < 640; i += NWAVES * 64) cw[i] = (i < 512) ? C.conv_w()[(i >> 7) * 1024 + n * 128 + (i & 127)] : C.conv_b()[n * 128 + (i - 512)];
    for (int i = tid; i < 1024; i += NWAVES * 64) { const int fl = i & 63, fi = i >> 6, gate = fi >> 3, nt = (fi >> 2) & 1, ks = fi & 3;
        const size_t o = (size_t)(n * 128 + 32 * eq + 16 * nt + (fl & 15)) * 128 + 32 * ks + 8 * (fl >> 4);
        wf[i] = *(const bf16x8*)((gate ? C.LWX() : C.LWA()) + o); }
    bf16x8 Id[2];
#pragma unroll
    for (int nt = 0; nt < 2; ++nt) {
#pragma unroll
        for (int j = 0; j < 8; ++j) Id[nt][j] = (8 * lg + j == 16 * nt + l15) ? (short)0x3F80 : (short)0;
    }
    float ba[2], bx[2], cl[2], hprev[2] = {0.f, 0.f};
#pragma unroll
    for (int nt = 0; nt < 2; ++nt) { const int ch = n * 128 + 32 * eq + 16 * nt + l15; ba[nt] = -1.4426950408889634f * C.lru_ba()[ch]; bx[nt] = -1.4426950408889634f * C.lru_bx()[ch]; cl[nt] = C.CLAM()[ch]; }
    __syncthreads();
    float cwl[5], cwh[5];
#pragma unroll
    for (int tp = 0; tp < 5; ++tp) { cwl[tp] = cw[tp * 128 + 2 * lane]; cwh[tp] = cw[tp * 128 + 2 * lane + 1]; }
    __syncthreads();
    const char* xbase = (const char*)(C.XR() + (size_t)b * SEQ * 1024 + n * 128);
    const char* ybase = (const char*)(C.YR() + (size_t)b * SEQ * 1024 + n * 128 + 32 * eq);
    char* obase = (char*)(C.COMB() + (size_t)(b * 16) * (256 * 1536) + (size_t)(8 + 2 * n + (eq >> 1)) * (256 * 64) + (eq & 1) * 32);
    v4u xr[9], yr[2];
#define LRU_LOAD(c_) do { const int tok0 = 256 * (c_) + 32 * wave - 3; \
        _Pragma("unroll") for (int k = 0; k < 9; ++k) { const int p = lane + 64 * k, tk = tok0 + (p >> 4); \
            v4u v = {0u, 0u, 0u, 0u}; if (p < 560 && tk >= 0) v = *(const v4u*)(xbase + ((unsigned)tk * 2048u + (unsigned)(p & 15) * 16u)); xr[k] = v; } } while (0)
#define LRU_LOADY(c_) do { _Pragma("unroll") for (int k = 0; k < 2; ++k) { const int q = lane + 64 * k; yr[k] = *(const v4u*)(ybase + ((unsigned)(256 * (c_) + 32 * wave + (q >> 2)) * 2048u + (unsigned)(q & 3) * 16u)); } } while (0)
#define LRU_STORE() do { \
        _Pragma("unroll") for (int k = 0; k < 9; ++k) { const int p = lane + 64 * k; if (p < 560) *(LAS v4u*)(XW + (p >> 4) * LRU_XROW + (p & 15) * 16) = xr[k]; } \
        _Pragma("unroll") for (int k = 0; k < 2; ++k) { const int q = lane + 64 * k; *(LAS v4u*)(YW + (q >> 2) * 64 + (q & 3) * 16) = yr[k]; } } while (0)
    LRU_LOAD(0); LRU_LOADY(0); LRU_STORE();
    LDS_WAIT(); asm volatile("" ::: "memory");
    v4u nr_w = {0u, 0u, 0u, 0u}; v4u* nr_p = nullptr; NrTab nr_T;
#pragma unroll 1
    for (int chunk = 0; chunk < 16; ++chunk) {
        if ((chunk & 1) == 0) { const int pair = 64 * strip + 8 * wave + (chunk >> 1), row = 2 * pair + (lane >> 5), vec = (lane >> 3) & 3;
            nr_p = (v4u*)(C.KV() + (size_t)row * 768 + ((vec < 2) ? 256 : 512) + (vec & 1) * 64 + (lane & 7) * 8); nr_w = *nr_p; }
        else { const int pair = 64 * strip + 8 * wave + (chunk >> 1), row = 2 * pair + (lane >> 5), vec = (lane >> 3) & 3;
            normrope8_prep(nr_T, C.k_norm_w() + ((vec < 2) ? 64 : 128), C, row & (SEQ - 1), lane & 7); }
        bf16x8 Af[2][4];
#pragma unroll
        for (int m = 0; m < 2; ++m) { unsigned xv[19];
#pragma unroll
          for (int r = 0; r < 19; ++r) xv[r] = *(const LAS unsigned*)(XW + (16 * m + r) * LRU_XROW + 4 * lane);
#pragma unroll
          for (int t = 0; t < 16; ++t) { float alo = cwl[4], ahi = cwh[4];
#pragma unroll
              for (int tp = 0; tp < 4; ++tp) { alo += cwl[tp] * __uint_as_float(xv[t + tp] << 16); ahi += cwh[tp] * __uint_as_float(xv[t + tp] & 0xffff0000u); }
              *(LAS unsigned*)(XW + (16 * m + t) * LRU_XROW + 4 * lane) = cvtpk2(alo, ahi); }
          LDS_WAIT(); asm volatile("" ::: "memory");
#pragma unroll
          for (int ks = 0; ks < 4; ++ks) Af[m][ks] = *(const LAS bf16x8*)(XW + (16 * m + l15) * LRU_XROW + ks * 64 + lg * 16);
          asm volatile("" : "+v"(Af[m][0]), "+v"(Af[m][1]), "+v"(Af[m][2]), "+v"(Af[m][3]) :: "memory");
        }
        if (chunk + 1 < 16) LRU_LOAD(chunk + 1);
        float Ap[2][2][4], Hp[2][2][4], Aex[2][2], Hex[2][2], Atot[2][2], Htot[2][2];
#pragma unroll
        for (int m = 0; m < 2; ++m) {
            const bf16x8 As = (eq == 0) ? Af[m][0] : (eq == 1) ? Af[m][1] : (eq == 2) ? Af[m][2] : Af[m][3];
#pragma unroll
            for (int nt = 0; nt < 2; ++nt) {
                f32x4 ga = {ba[nt], ba[nt], ba[nt], ba[nt]}, gx = {bx[nt], bx[nt], bx[nt], bx[nt]};
#pragma unroll
                for (int ks = 0; ks < 4; ++ks) { ga = MFMA16(Af[m][ks], wf[((0 * 2 + nt) * 4 + ks) * 64 + lane], ga); gx = MFMA16(Af[m][ks], wf[((1 * 2 + nt) * 4 + ks) * 64 + lane], gx); }
                const f32x4 xc = MFMA16(As, Id[nt], ((f32x4){0.f, 0.f, 0.f, 0.f}));
                float A = 1.f, H = 0.f;
#pragma unroll
                for (int r = 0; r < 4; ++r) {
                    const float ra = __builtin_amdgcn_rcpf(1.0f + __builtin_amdgcn_exp2f(ga[r])), ix = __builtin_amdgcn_rcpf(1.0f + __builtin_amdgcn_exp2f(gx[r]));
                    const float e2 = cl[nt] * ra, a = __builtin_amdgcn_exp2f(e2);
                    const float om = __builtin_fmaf(-a, a, 1.0f);
                    const float bt = __builtin_amdgcn_sqrtf(om) * (ix * xc[r]);
                    H = a * H + bt; A = a * A; Ap[m][nt][r] = A; Hp[m][nt][r] = H;
                }
                { const auto sa = __builtin_amdgcn_permlane16_swap(__float_as_uint(A), __float_as_uint(A), false, false), sh = __builtin_amdgcn_permlane16_swap(__float_as_uint(H), __float_as_uint(H), false, false);
                  const bool odd = (lg & 1) != 0, up = (lg >= 2);
                  const float PA = __uint_as_float(odd ? sa[0] : sa[1]), PH = __uint_as_float(odd ? sh[0] : sh[1]);
                  const float TA = A * PA, TH = odd ? (A * PH + H) : (PA * H + PH);
                  const auto qa = __builtin_amdgcn_permlane32_swap(__float_as_uint(TA), __float_as_uint(TA), false, false), qh = __builtin_amdgcn_permlane32_swap(__float_as_uint(TH), __float_as_uint(TH), false, false);
                  const float QA = __uint_as_float(up ? qa[0] : qa[1]), QH = __uint_as_float(up ? qh[0] : qh[1]);
                  float Ae = 1.f, He = 0.f;
                  if (lg == 1) { Ae = PA; He = PH; } else if (lg == 2) { Ae = QA; He = QH; } else if (lg == 3) { Ae = QA * PA; He = PA * QH + PH; }
                  Aex[m][nt] = Ae; Hex[m][nt] = He;
                  Atot[m][nt] = TA * QA; Htot[m][nt] = up ? (TA * QH + TH) : (QA * TH + QH); }
                asm volatile("" : "+v"(Atot[m][nt]), "+v"(Htot[m][nt]) :: "memory");
            }
        }
        LAS float* xp = xch + (chunk & 1) * 512;
        if (lg == 0) {
#pragma unroll
            for (int nt = 0; nt < 2; ++nt) { xp[(wave * 32 + 16 * nt + l15) * 2] = Atot[0][nt] * Atot[1][nt]; xp[(wave * 32 + 16 * nt + l15) * 2 + 1] = Atot[1][nt] * Htot[0][nt] + Htot[1][nt]; }
        }
        if (chunk + 1 < 16) LRU_LOADY(chunk + 1);
        __syncthreads();
#pragma unroll
        for (int nt = 0; nt < 2; ++nt) { float h = hprev[nt], hw = h;
#pragma unroll
            for (int w2 = 0; w2 < 8; ++w2) { if (w2 == wave) hw = h; const float Aw = xp[(w2 * 32 + 16 * nt + l15) * 2], Hw = xp[(w2 * 32 + 16 * nt + l15) * 2 + 1]; h = Aw * h + Hw; }
            hprev[nt] = h;
#pragma unroll
            for (int m = 0; m < 2; ++m) { const float hg = Aex[m][nt] * hw + Hex[m][nt];
#pragma unroll
                for (int r = 0; r < 4; ++r) { const float hv = Ap[m][nt][r] * hg + Hp[m][nt][r]; const float yv = bf2f(*(const LAS bf16*)(YW + (16 * m + 4 * lg + r) * 64 + 32 * nt + 2 * l15));
                    *(LAS bf16*)(OW + (16 * m + 4 * lg + r) * 64 + 32 * nt + 2 * l15) = (bf16)(cvtpk2(hv * gelu_tanh(yv), 0.f) & 0xffffu); }
                hw = Atot[m][nt] * hw + Htot[m][nt]; } }
        LDS_WAIT(); asm volatile("" ::: "memory");
#pragma unroll
        for (int k = 0; k < 2; ++k) { const int q = lane + 64 * k; const v4u ov = *(const LAS v4u*)(OW + q * 16);
            *(v4u*)(obase + ((unsigned)chunk * (256u * 1536u * 2u) + (unsigned)(32 * wave + (q >> 2)) * 128u + (unsigned)(q & 3) * 16u)) = ov; }
        if (chunk + 1 < 16) LRU_STORE();
        if (chunk & 1) { normrope8_apply(nr_w, nr_T, lane & 7, 1.0f); *nr_p = nr_w; }
        LDS_WAIT(); asm volatile("" ::: "memory");
    }
#undef LRU_LOAD
#undef LRU_LOADY
#undef LRU_STORE
    __syncthreads();
}

DI void rope_norm_lane(float& v, const float* nw, const Ctx& C, int pos, int lane, bool do_norm) {
    if (do_norm) { const float ss = wave_sum(v * v); v = v * rsqrtf(ss * (1.0f / 64.0f) + 1e-6f) * nw[lane]; }
    const float other = __shfl_xor(v, 8);
    if (lane < 16) { const float c = C.ROPE_C()[pos * 8 + (lane & 7)], s = C.ROPE_S()[pos * 8 + (lane & 7)]; v = (lane < 8) ? v * c - other * s : v * c + other * s; }
}
DI void compress_item(const Ctx& C, int item, LAS unsigned char* lds) {
    const int tid = C.tid, lane = C.lane, wave = C.wave, l15 = lane & 15, lg = lane >> 4;
    const int kv = item >> 7, b = (item >> 4) & 7, g = (item >> 3) & 1, i0 = (item & 7) * 32;
    const bf16* W1F = kv ? C.PV1() : C.PK1(); const bf16* W2T = kv ? C.PV2() : C.PK2();
    LAS unsigned char* AS = lds;
    LAS bf16* hid = (LAS bf16*)(lds + 67584);
    LAS float* outs = (LAS float*)(lds + 67584 + 32 * 264 * 2);
    { const char* base = (const char*)(C.KV() + (size_t)(b * SEQ + 16 * i0) * 768 + kv * 128 + g * 64);
      v4u st[9];
#pragma unroll
      for (int k = 0; k < 9; ++k) { const int p = tid + 512 * k, r = p >> 3; v4u v = {0u, 0u, 0u, 0u}; if (p < 4224 && 16 * i0 + r < SEQ) v = *(const v4u*)(base + (size_t)r * 1536 + (p & 7) * 16); st[k] = v; }
#pragma unroll
      for (int k = 0; k < 9; ++k) { const int p = tid + 512 * k, r = p >> 3; if (p < 4224) *(LAS v4u*)(AS + r * 128 + (((p & 7) ^ ((r >> 4) & 7)) * 16)) = st[k]; } }
    const float bi0 = C.PHIB()[kv * 256 + 32 * wave + l15], bi1 = C.PHIB()[kv * 256 + 32 * wave + 16 + l15];
    int arow[2];
#pragma unroll
    for (int m = 0; m < 2; ++m) { const int bl = (i0 + 16 * m + l15 < 255) ? 16 * m + l15 : 254 - i0; arow[m] = 16 * bl; }
    const bf16* bp = W1F + ((size_t)(2 * wave) * 64 + lane) * 8;
    f32x4 acc[2][2];
#pragma unroll
    for (int m = 0; m < 2; ++m)
#pragma unroll
        for (int t = 0; t < 2; ++t) acc[m][t] = (f32x4){0.f, 0.f, 0.f, 0.f};
    bf16x8 fb0[4][2], fb1[4][2];
#define CMP_LOAD(FB, kb_) do { _Pragma("unroll") for (int s_ = 0; s_ < 4; ++s_) { const int ks = 4 * (kb_) + s_; \
        FB[s_][0] = *(const bf16x8*)(bp + (size_t)(ks * 16) * 512); FB[s_][1] = *(const bf16x8*)(bp + (size_t)(ks * 16 + 1) * 512); } } while (0)
#define CMP_MMA(FB, kb_) do { _Pragma("unroll") for (int s_ = 0; s_ < 4; ++s_) { const int ks = 4 * (kb_) + s_, j = ks >> 1, ch = (ks & 1) * 4 + lg; \
        const int r0 = arow[0] + j, r1 = arow[1] + j; \
        const bf16x8 a0 = *(const LAS bf16x8*)(AS + r0 * 128 + ((ch ^ ((r0 >> 4) & 7)) * 16)), a1 = *(const LAS bf16x8*)(AS + r1 * 128 + ((ch ^ ((r1 >> 4) & 7)) * 16)); \
        acc[0][0] = MFMA16(a0, FB[s_][0], acc[0][0]); acc[0][1] = MFMA16(a0, FB[s_][1], acc[0][1]); acc[1][0] = MFMA16(a1, FB[s_][0], acc[1][0]); acc[1][1] = MFMA16(a1, FB[s_][1], acc[1][1]); } } while (0)
    CMP_LOAD(fb0, 0);
    __syncthreads();
#pragma unroll 1
    for (int kb = 0; kb < 16; kb += 2) {
        CMP_LOAD(fb1, kb + 1); asm volatile("" ::: "memory");
        CMP_MMA(fb0, kb);
        asm volatile("" : "+v"(acc[0][0]), "+v"(acc[0][1]), "+v"(acc[1][0]), "+v"(acc[1][1]) :: "memory");
        if (kb + 2 < 16) CMP_LOAD(fb0, kb + 2);
        asm volatile("" ::: "memory");
        CMP_MMA(fb1, kb + 1);
        asm volatile("" : "+v"(acc[0][0]), "+v"(acc[0][1]), "+v"(acc[1][0]), "+v"(acc[1][1]) :: "memory");
    }
#undef CMP_LOAD
#undef CMP_MMA
#ifdef PROBE_TS
    if (blockIdx.x == 0 && C.tid == 0) ((unsigned long long*)(C.ws + 256))[11] = rt();
#endif
    const int m2 = wave >> 2, nt2 = wave & 3;
    bf16x8 w2f[8];
#pragma unroll
    for (int ks = 0; ks < 8; ++ks) w2f[ks] = *(const bf16x8*)(W2T + (size_t)(16 * nt2 + l15) * 256 + ks * 32 + 8 * lg);
#pragma unroll
    for (int m = 0; m < 2; ++m)
#pragma unroll
        for (int r = 0; r < 4; ++r) { hid[(16 * m + 4 * lg + r) * 264 + 32 * wave + l15] = (bf16)f2bf(gelu_tanh(acc[m][0][r] + bi0)); hid[(16 * m + 4 * lg + r) * 264 + 32 * wave + 16 + l15] = (bf16)f2bf(gelu_tanh(acc[m][1][r] + bi1)); }
    __syncthreads();
    { f32x4 acc2 = {0.f, 0.f, 0.f, 0.f};
#pragma unroll
      for (int ks = 0; ks < 8; ++ks) { const bf16x8 a = *(const LAS bf16x8*)(hid + (16 * m2 + l15) * 264 + ks * 32 + 8 * lg); acc2 = MFMA16(a, w2f[ks], acc2); }
#pragma unroll
      for (int r = 0; r < 4; ++r) outs[(16 * m2 + 4 * lg + r) * 64 + 16 * nt2 + l15] = acc2[r]; }
    float rc[4], rsn[4]; const float nw = C.k_norm_w()[lane];
#pragma unroll
    for (int rr = 0; rr < 4; ++rr) { const int i = i0 + 4 * wave + rr, pos = (i < 255) ? 16 * i + 31 : 31; rc[rr] = C.ROPE_C()[pos * 8 + (lane & 7)]; rsn[rr] = C.ROPE_S()[pos * 8 + (lane & 7)]; }
    __syncthreads();
#pragma unroll
    for (int rr = 0; rr < 4; ++rr) { const int row = 4 * wave + rr, i = i0 + row;
        float v = outs[row * 64 + lane];
        if (kv == 0) { const float ss = wave_sum(v * v); v = v * rsqrtf(ss * (1.0f / 64.0f) + 1e-6f) * nw;
            const float other = __shfl_xor(v, 8);
            if (lane < 16) v = (lane < 8) ? v * rc[rr] - other * rsn[rr] : v * rc[rr] + other * rsn[rr]; }
        if (i < 255) (kv ? C.VC() : C.KC())[(size_t)((b * 2 + g) * 256 + i) * 64 + lane] = (bf16)f2bf(v); }
    __syncthreads();
}

#if defined(NAIVE_ATTN) || defined(PROBE_ATTN_CHECK)
DI void dot4(const bf16* kp, const LAS float* qs, float (&d)[4]) {
    d[0] = d[1] = d[2] = d[3] = 0.f;
#pragma unroll 1
    for (int c = 0; c < 8; ++c) {
        const v4u kw = *(const v4u*)(kp + 8 * c);
        const float k0 = __uint_as_float(kw.x << 16), k1 = __uint_as_float(kw.x & 0xffff0000u), k2 = __uint_as_float(kw.y << 16), k3 = __uint_as_float(kw.y & 0xffff0000u);
        const float k4 = __uint_as_float(kw.z << 16), k5 = __uint_as_float(kw.z & 0xffff0000u), k6 = __uint_as_float(kw.w << 16), k7 = __uint_as_float(kw.w & 0xffff0000u);
#pragma unroll
        for (int h = 0; h < 4; ++h) { const f32x4 qa = *(const LAS f32x4*)(qs + h * 64 + 8 * c), qb = *(const LAS f32x4*)(qs + h * 64 + 8 * c + 4);
            d[h] += (k0 * qa[0] + k1 * qa[1]) + (k2 * qa[2] + k3 * qa[3]) + (k4 * qb[0] + k5 * qb[1]) + (k6 * qb[2] + k7 * qb[3]); }
    }
}
DI void attend_blocks(const Ctx& C, int b, int t, unsigned long long mask, int kcol, int vcol, int lo, const LAS float* qs, LAS float* ps, float (&o)[4]) {
    const int lane = C.lane;
    float mloc[4] = {-1e30f, -1e30f, -1e30f, -1e30f};
    for (unsigned long long mm = mask; mm; mm &= mm - 1) {
        asm volatile("" ::: "memory");
        const int j = __builtin_ctzll(mm), tok = 64 * j + lane; const bool valid = tok >= lo && tok <= t;
        float d[4]; dot4(C.KV() + (size_t)(b * SEQ + tok) * 768 + kcol, qs, d);
#pragma unroll
        for (int h = 0; h < 4; ++h) if (valid) mloc[h] = fmaxf(mloc[h], d[h]);
    }
    float mx[4], lp[4] = {0.f, 0.f, 0.f, 0.f};
#pragma unroll
    for (int h = 0; h < 4; ++h) { mx[h] = wave_max(mloc[h]); o[h] = 0.f; }
    for (unsigned long long mm = mask; mm; mm &= mm - 1) {
        asm volatile("" ::: "memory");
        const int j = __builtin_ctzll(mm), tok = 64 * j + lane; const bool valid = tok >= lo && tok <= t;
        float d[4]; dot4(C.KV() + (size_t)(b * SEQ + tok) * 768 + kcol, qs, d);
#pragma unroll
        for (int h = 0; h < 4; ++h) { const float p = valid ? exp2f(d[h] - mx[h]) : 0.f; lp[h] += p; ps[h * 64 + lane] = p; }
        LDS_WAIT(); asm volatile("" ::: "memory");
        const bf16* vp = C.KV() + (size_t)(b * SEQ + 64 * j) * 768 + vcol + lane;
#pragma unroll 4
        for (int kk = 0; kk < 64; ++kk) { const float v = bf2f(vp[(size_t)kk * 768]);
#pragma unroll
            for (int h = 0; h < 4; ++h) o[h] += ps[h * 64 + kk] * v; }
        LDS_WAIT(); asm volatile("" ::: "memory");
    }
#pragma unroll
    for (int h = 0; h < 4; ++h) o[h] /= wave_sum(lp[h]);
}
DI void attn_naive(const Ctx& C, int qidx, LAS float* wl, bf16* onsa) {
    const int lane = C.lane, b = qidx >> 13, g = (qidx >> 12) & 1, t = qidx & (SEQ - 1), row = b * SEQ + t;
    LAS float* qs = wl; LAS float* ps = wl + 256; LAS float* psum = wl + 256 + 1024;
#pragma unroll
    for (int h = 0; h < 4; ++h) { float v = bf2f(C.Q()[(size_t)row * 512 + (g * 4 + h) * 64 + lane]); rope_norm_lane(v, C.q_norm_w(), C, t, lane, true); qs[h * 64 + lane] = bf2f((bf16)(cvtpk2(v * 0.18033688011112042f, 0.f) & 0xffffu)); }
#pragma unroll
    for (int i = 0; i < 4; ++i) psum[i * 64 + lane] = 0.f;
    LDS_WAIT(); asm volatile("" ::: "memory");
    float gate[3][4], otot[4] = {0.f, 0.f, 0.f, 0.f};
#pragma unroll
    for (int br = 0; br < 3; ++br)
#pragma unroll
        for (int h = 0; h < 4; ++h) gate[br][h] = sigm(bf2f(C.GN()[(size_t)row * 32 + br * 8 + g * 4 + h]));
    const int nv = (t >= 31) ? ((t - 31) >> 4) + 1 : 0;
    if (nv > 0) {
        float sc[4][4];
#pragma unroll
        for (int rd = 0; rd < 4; ++rd) { asm volatile("" ::: "memory"); const int n = rd * 64 + lane; const bool valid = n < nv;
            float d[4]; dot4(C.KC() + (size_t)((b * 2 + g) * 256 + (valid ? n : 0)) * 64, qs, d);
#pragma unroll
            for (int h = 0; h < 4; ++h) sc[rd][h] = valid ? d[h] : -1e30f; }
        float pacc[4] = {0.f, 0.f, 0.f, 0.f};
#pragma unroll
        for (int h = 0; h < 4; ++h) {
            const float m = wave_max(fmaxf(fmaxf(sc[0][h], sc[1][h]), fmaxf(sc[2][h], sc[3][h])));
            float e[4], l = 0.f;
#pragma unroll
            for (int rd = 0; rd < 4; ++rd) { e[rd] = (rd * 64 + lane < nv) ? exp2f(sc[rd][h] - m) : 0.f; l += e[rd]; }
            const float inv = 1.0f / wave_sum(l);
#pragma unroll
            for (int rd = 0; rd < 4; ++rd) { const float p = e[rd] * inv; ps[h * 256 + rd * 64 + lane] = p; pacc[rd] += p; }
        }
#pragma unroll
        for (int rd = 0; rd < 4; ++rd) psum[rd * 64 + lane] = pacc[rd];
        LDS_WAIT(); asm volatile("" ::: "memory");
        float oc[4] = {0.f, 0.f, 0.f, 0.f};
        const bf16* vp = C.VC() + (size_t)((b * 2 + g) * 256) * 64 + lane;
        for (int n = 0; n < nv; ++n) { const float v = bf2f(vp[n * 64]);
#pragma unroll
            for (int h = 0; h < 4; ++h) oc[h] += ps[h * 256 + n] * v; }
#pragma unroll
        for (int h = 0; h < 4; ++h) otot[h] += gate[0][h] * oc[h];
    }
    LDS_WAIT(); asm volatile("" ::: "memory");
    const int cur = t >> 6;
    float imp = 0.f;
#pragma unroll
    for (int k = -1; k <= 3; ++k) { const int n = 4 * lane + k; if (n >= 0 && n < 255) imp += psum[n]; }
    const float score = (lane > cur) ? -1e30f : ((lane == 0 || lane == cur || lane == cur - 1) ? 1e4f : imp);
    int cnt = 0;
#pragma unroll 4
    for (int jj = 0; jj < 64; ++jj) { const float sj = __shfl(score, jj); cnt += (sj > score || (sj == score && jj < lane)) ? 1 : 0; }
    unsigned long long sel = __ballot(cnt < 16);
    sel &= (cur == 63) ? ~0ull : ((1ull << (cur + 1)) - 1ull);
    LDS_WAIT(); asm volatile("" ::: "memory");
    float o[4];
    attend_blocks(C, b, t, sel, 256 + g * 64, 384 + g * 64, 0, qs, ps, o);
#pragma unroll
    for (int h = 0; h < 4; ++h) otot[h] += gate[1][h] * o[h];
    const int lo = (t >= 511) ? t - 511 : 0;
    unsigned long long wm = 0ull;
    for (int j = lo >> 6; j <= cur; ++j) wm |= 1ull << j;
    attend_blocks(C, b, t, wm, 512 + g * 64, 640 + g * 64, lo, qs, ps, o);
#pragma unroll
    for (int h = 0; h < 4; ++h) { otot[h] += gate[2][h] * o[h]; onsa[(size_t)row * 1536 + (g * 4 + h) * 64 + lane] = (bf16)f2bf(otot[h]); }
}
#endif
namespace fa {
typedef short s16x4 __attribute__((ext_vector_type(4)));
typedef short v4i16_t __attribute__((ext_vector_type(4)));
typedef float f32x2_t __attribute__((ext_vector_type(2)));
typedef __bf16 bf16x2_t __attribute__((ext_vector_type(2)));
typedef LAS const char* lds_cptr;
constexpr int L_K = 0, L_V = 16384, L_WSF = 40960, L_PW = 43008, L_SEL = 108544, L_END = 109056;
constexpr float NEGF = -1e30f, THR = 8.0f;
DI int crow(int r, int hi) { return (r & 3) + 8 * (r >> 2) + 4 * hi; }
DI unsigned cvtpk(float lo, float hi) { f32x2_t v = {lo, hi}; bf16x2_t b = __builtin_convertvector(v, bf16x2_t); return __builtin_bit_cast(unsigned, b); }
DI s16x4 vtr(lds_cptr p) { return __builtin_bit_cast(s16x4, __builtin_amdgcn_ds_read_tr16_b64_v4i16((LAS v4i16_t*)p)); }
DI float swap_max(float m) { auto rr = __builtin_amdgcn_permlane32_swap(__float_as_uint(m), __float_as_uint(m), false, false); return fmaxf(__uint_as_float(rr[0]), __uint_as_float(rr[1])); }
DI float swap_sum(float m) { auto rr = __builtin_amdgcn_permlane32_swap(__float_as_uint(m), __float_as_uint(m), false, false); return __uint_as_float(rr[0]) + __uint_as_float(rr[1]); }
DI float quad_sum(float x) {
    float y = __int_as_float(__builtin_amdgcn_update_dpp(0, __float_as_int(x), 0xB1, 0xF, 0xF, true)); x += y;
    y = __int_as_float(__builtin_amdgcn_update_dpp(0, __float_as_int(x), 0x4E, 0xF, 0xF, true)); return x + y; }
#define FA_MFMA32(a, b, c) __builtin_amdgcn_mfma_f32_32x32x16_bf16((a), (b), (c), 0, 0, 0)

DI void qkt(f32x16& p0, f32x16& p1, lds_cptr kslot, const bf16x8 (&qr)[4], const f32x16& cinit, int r32, int hi) {
    const lds_cptr kb = kslot + hi * 1024 + r32 * 16;
    bf16x8 kf[8];
#pragma unroll
    for (int d0 = 0; d0 < 4; ++d0) { kf[2 * d0] = *(const LAS bf16x8*)(kb + d0 * 2048); kf[2 * d0 + 1] = *(const LAS bf16x8*)(kb + d0 * 2048 + 512); }
    asm volatile("" : "+v"(kf[0]), "+v"(kf[1]), "+v"(kf[2]), "+v"(kf[3]), "+v"(kf[4]), "+v"(kf[5]), "+v"(kf[6]), "+v"(kf[7]));
    p0 = cinit; p1 = cinit;
#pragma unroll
    for (int d0 = 0; d0 < 4; ++d0) { p0 = FA_MFMA32(kf[2 * d0], qr[d0], p0); p1 = FA_MFMA32(kf[2 * d0 + 1], qr[d0], p1); }
}
DI void v_load(bf16x8 (&vf)[8], lds_cptr vslot, int lane, int hi) {
    const lds_cptr vb = vslot + ((lane >> 4) & 1) * 32 + (lane & 3) * 8 + (4 * hi + ((lane & 15) >> 2)) * 64;
#pragma unroll
    for (int d0 = 0; d0 < 2; ++d0)
#pragma unroll
        for (int ks = 0; ks < 4; ++ks) {
            const s16x4 lo = vtr(vb + d0 * 4096 + ks * 1024), hh = vtr(vb + d0 * 4096 + ks * 1024 + 512);
            vf[d0 * 4 + ks] = (bf16x8){lo[0], lo[1], lo[2], lo[3], hh[0], hh[1], hh[2], hh[3]};
        }
    asm volatile("" : "+v"(vf[0]), "+v"(vf[1]), "+v"(vf[2]), "+v"(vf[3]), "+v"(vf[4]), "+v"(vf[5]), "+v"(vf[6]), "+v"(vf[7]));
}
DI void pv(f32x16 (&o)[2], const bf16x8 (&vf)[8], const f32x16& p0, const f32x16& p1) {
    bf16x8 pa[4];
#pragma unroll
    for (int s = 0; s < 2; ++s) {
        v4u w0, w1;
        w0.x = cvtpk(p0[8 * s], p0[8 * s + 1]); w0.y = cvtpk(p0[8 * s + 2], p0[8 * s + 3]); w0.z = cvtpk(p0[8 * s + 4], p0[8 * s + 5]); w0.w = cvtpk(p0[8 * s + 6], p0[8 * s + 7]);
        w1.x = cvtpk(p1[8 * s], p1[8 * s + 1]); w1.y = cvtpk(p1[8 * s + 2], p1[8 * s + 3]); w1.z = cvtpk(p1[8 * s + 4], p1[8 * s + 5]); w1.w = cvtpk(p1[8 * s + 6], p1[8 * s + 7]);
        pa[s] = __builtin_bit_cast(bf16x8, w0); pa[2 + s] = __builtin_bit_cast(bf16x8, w1);
    }
#pragma unroll
    for (int ks = 0; ks < 4; ++ks) { o[0] = FA_MFMA32(pa[ks], vf[ks], o[0]); o[1] = FA_MFMA32(pa[ks], vf[4 + ks], o[1]); }
}
DI float rowmax32(const f32x16& p0, const f32x16& p1) {
    float a = fmaxf(p0[0], p1[0]);
#pragma unroll
    for (int r = 1; r < 16; ++r) a = fmaxf(a, fmaxf(p0[r], p1[r]));
    return swap_max(a);
}
struct Tile { const bf16* kp; const bf16* vp; int stride; };

DI void attn_unit(const Ctx& C, int b, int g, int qt, int wslot, LAS unsigned char* lds) {
    const int lane = C.lane, wave = C.wave, r32 = lane & 31, hi = lane >> 5, qi = r32 >> 2, h = r32 & 3;
    const int ql = 8 * wave + qi, t = 64 * qt + ql, cur = qt;
    const size_t tokrow = (size_t)b * SEQ + t;
    const lds_cptr L = (lds_cptr)lds;
    LAS float* wsf = (LAS float*)(lds + L_WSF + wave * 256);
    LAS float* pw = (LAS float*)(lds + L_PW + wave * 8192); LAS float* impG = pw; LAS float* impE = pw + 8 * 65;
    LAS unsigned* selw = (LAS unsigned*)(lds + L_SEL);
#ifdef PROBE_TS
#define FA_STAMP(k) do { if (blockIdx.x == 0 && C.tid == 0 && qt == 63) ((unsigned long long*)(C.ws + 256))[k] = rt(); } while (0)
#else
#define FA_STAMP(k) do {} while (0)
#endif
    FA_STAMP(12);
#define FA_GATE(br) ({ int l_ = lane; asm volatile("" : "+v"(l_)); sigm(bf2f(C.GN()[((size_t)b * SEQ + 64 * qt + 8 * wave + ((l_ & 31) >> 2)) * 32 + (br) * 8 + g * 4 + (l_ & 3)])); })
    float wcv[3][8]; WconvItem wcI[3]; bool wcon[3];
#pragma unroll
    for (int j = 0; j < 3; ++j) { wcon[j] = wconv_decode(C, (wslot * 3 + j) * (C.G * NWAVES) + C.vcu * NWAVES + wave, lane, wcI[j]);
#pragma unroll
        for (int e = 0; e < 8; ++e) wcv[j][e] = wcon[j] ? wcI[j].src[(size_t)e * wcI[j].ldn] : 0.f; }
    const int nct = (4 * qt + 3 + 63) >> 6;
    const int nslc = cur + 1, w_lo = (qt >= 8) ? qt - 8 : 0, nwin = qt - w_lo + 1;
    const int i_b = nct, i_c = 2 * nct, i_d = i_c + nslc, ntile = i_d + nwin;
    const bf16* kcb = C.KC() + (size_t)((b * 2 + g) * 256) * 64; const bf16* vcb = C.VC() + (size_t)((b * 2 + g) * 256) * 64;
    const bf16* kvb = C.KV() + (size_t)b * SEQ * 768 + g * 64;
    const int krow = lane, kcol = 8 * wave, vrow = 16 * (wave & 3) + (lane >> 2), vcol = (wave >> 2) * 32 + (lane & 3) * 8;
    auto tile_of = [&](int i_) -> Tile {
        Tile T; const int i = (i_ < ntile) ? i_ : ntile - 1;
        if (i < i_c) { const int kt = (i < i_b) ? i : i - i_b; T.stride = 64; T.kp = kcb + (size_t)(64 * kt + krow) * 64 + kcol; T.vp = (i < i_b) ? nullptr : vcb + (size_t)(64 * kt + vrow) * 64 + vcol; }
        else if (i < i_d) { const int j = i - i_c; T.stride = 768; T.kp = kvb + (size_t)(64 * j + krow) * 768 + 256 + kcol; T.vp = kvb + (size_t)(64 * j + vrow) * 768 + 384 + vcol; }
        else { const int kt = qt - (i - i_d); T.stride = 768; T.kp = kvb + (size_t)(64 * kt + krow) * 768 + 512 + kcol; T.vp = kvb + (size_t)(64 * kt + vrow) * 768 + 640 + vcol; }
        return T;
    };
    v4u kreg, vreg = {0u, 0u, 0u, 0u};
    bool hasv = false;
    { const Tile T0 = tile_of(0); kreg = *(const v4u*)T0.kp; if (T0.vp) vreg = *(const v4u*)T0.vp; }
    *(LAS v4u*)(lds + L_K + wave * 1024 + lane * 16) = kreg; *(LAS v4u*)(lds + L_V + wave * 1024 + lane * 16) = vreg;
    int vprev = 2, vcur = 0, vnext = 1;
    const int ntile_eff = ntile + (((ntile - i_c) & 1) ? 0 : 1);
    bf16x8 qr[4];
    { const bf16* qp = C.Q() + tokrow * 512 + (g * 4 + h) * 64 + 8 * hi;
      float qv[4][8]; float ss = 0.f;
#pragma unroll
      for (int d0 = 0; d0 < 4; ++d0) { const v4u w = *(const v4u*)(qp + 16 * d0);
          qv[d0][0] = __uint_as_float(w.x << 16); qv[d0][1] = __uint_as_float(w.x & 0xffff0000u); qv[d0][2] = __uint_as_float(w.y << 16); qv[d0][3] = __uint_as_float(w.y & 0xffff0000u);
          qv[d0][4] = __uint_as_float(w.z << 16); qv[d0][5] = __uint_as_float(w.z & 0xffff0000u); qv[d0][6] = __uint_as_float(w.w << 16); qv[d0][7] = __uint_as_float(w.w & 0xffff0000u);
#pragma unroll
          for (int j = 0; j < 8; ++j) ss += qv[d0][j] * qv[d0][j]; }
      ss = swap_sum(ss);
      const float rs = rsqrtf(ss * (1.0f / 64.0f) + 1e-6f) * 0.18033688011112042f;
      const float* qw = C.q_norm_w() + 8 * hi;
#pragma unroll
      for (int d0 = 0; d0 < 4; ++d0) { const f32x4 wa = *(const f32x4*)(qw + 16 * d0), wb = *(const f32x4*)(qw + 16 * d0 + 4);
#pragma unroll
          for (int j = 0; j < 4; ++j) { qv[d0][j] *= rs * wa[j]; qv[d0][4 + j] *= rs * wb[j]; } }
      { const f32x4 c0 = *(const f32x4*)(C.ROPE_C() + t * 8), c1 = *(const f32x4*)(C.ROPE_C() + t * 8 + 4), s0 = *(const f32x4*)(C.ROPE_S() + t * 8), s1 = *(const f32x4*)(C.ROPE_S() + t * 8 + 4);
#pragma unroll
        for (int j = 0; j < 8; ++j) { const float own = qv[0][j], other = __shfl_xor(own, 32); const float c = (j < 4) ? c0[j & 3] : c1[j & 3], s = (j < 4) ? s0[j & 3] : s1[j & 3];
            qv[0][j] = hi ? own * c + other * s : own * c - other * s; } }
#pragma unroll
      for (int d0 = 0; d0 < 4; ++d0) { v4u w; w.x = cvtpk(qv[d0][0], qv[d0][1]); w.y = cvtpk(qv[d0][2], qv[d0][3]); w.z = cvtpk(qv[d0][4], qv[d0][5]); w.w = cvtpk(qv[d0][6], qv[d0][7]); qr[d0] = __builtin_bit_cast(bf16x8, w); } }
    __syncthreads();

    f32x16 o[2], p0, p1, zero16;
#pragma unroll
    for (int r = 0; r < 16; ++r) { o[0][r] = 0.f; o[1][r] = 0.f; zero16[r] = 0.f; }
    float lsum = 0.f, invl = 0.f;
    const int nvrow = (t >= 31) ? ((t - 31) >> 4) + 1 : 0;
    const int qlm = ql - 4 * hi;
    int i = 0;
#define FA_PREFETCH() const bool more = (i + 1 < ntile_eff); hasv = false; \
        if (more) { const Tile Tn = tile_of(i + 1); kreg = *(const v4u*)Tn.kp; hasv = (Tn.vp != nullptr); if (hasv) vreg = *(const v4u*)Tn.vp; } \
        const lds_cptr kslot = L + L_K + (i & 1) * 8192, vslot = L + L_V + vcur * 8192; (void)vslot
#define FA_COMMIT() do { if (more) { *(LAS v4u*)(lds + L_K + ((i + 1) & 1) * 8192 + wave * 1024 + lane * 16) = kreg; if (hasv) *(LAS v4u*)(lds + L_V + vnext * 8192 + wave * 1024 + lane * 16) = vreg; } \
        __syncthreads(); vprev = vcur; vcur = vnext; vnext = (vnext == 2) ? 0 : vnext + 1; } while (0)
    for (; i < i_b; ++i) {
        FA_PREFETCH();
        qkt(p0, p1, kslot, qr, zero16, r32, hi);
        const int nb = 64 * i + 4 * hi;
#pragma unroll
        for (int r = 0; r < 16; ++r) { const int c = (r & 3) + 8 * (r >> 2); if (nb + c >= nvrow) p0[r] = NEGF; if (nb + c + 32 >= nvrow) p1[r] = NEGF; }
        float s = 0.f;
#pragma unroll
        for (int r = 0; r < 16; ++r) s += __builtin_amdgcn_exp2f(p0[r]) + __builtin_amdgcn_exp2f(p1[r]);
        lsum += s;
        FA_COMMIT();
    }
    { const float lt = swap_sum(lsum); invl = (nvrow > 0) ? __builtin_amdgcn_rcpf(lt) : 0.f; }
    FA_STAMP(15);
    for (; i < i_c; ++i) {
        FA_PREFETCH();
        const int kt = i - i_b;
        qkt(p0, p1, kslot, qr, zero16, r32, hi);
        const int nb = 64 * kt + 4 * hi;
#pragma unroll
        for (int r = 0; r < 16; ++r) { const int c = (r & 3) + 8 * (r >> 2);
            p0[r] = (nb + c < nvrow) ? __builtin_amdgcn_exp2f(p0[r]) * invl : 0.f; p1[r] = (nb + c + 32 < nvrow) ? __builtin_amdgcn_exp2f(p1[r]) * invl : 0.f; }
        { bf16x8 vf[8]; v_load(vf, vslot, lane, hi); pv(o, vf, p0, p1); }
#pragma unroll
        for (int pp = 0; pp < 2; ++pp)
#pragma unroll
            for (int rr = 0; rr < 4; ++rr) {
                float v[4];
#pragma unroll
                for (int k = 0; k < 4; ++k) v[k] = quad_sum(pp ? p1[4 * rr + k] : p0[4 * rr + k]);
                if (h == 0) { const int m = 16 * kt + 8 * pp + 2 * rr + hi; impG[qi * 65 + m] = (v[0] + v[1]) + (v[2] + v[3]); impE[qi * 65 + m] = v[3]; }
            }
        FA_COMMIT();
    }
    FA_STAMP(16);
    { const unsigned long long lanebit = 1ull << lane;
      const unsigned long long valid = (cur == 63) ? ~0ull : ((1ull << (cur + 1)) - 1ull);
      const unsigned long long forced = 1ull | (1ull << cur) | ((cur >= 1) ? (1ull << (cur - 1)) : 0ull);
      const unsigned long long candm = valid & ~forced;
      const int ncand = (cur >= 2) ? cur - 2 : 0;
      if (ncand > 13) {
          unsigned key[8], T[8];
#pragma unroll
          for (int q8 = 0; q8 < 8; ++q8) { float imp = impG[q8 * 65 + lane]; if (lane >= 1) imp += impE[q8 * 65 + lane - 1];
              key[q8] = ((candm & lanebit) != 0ull) ? __float_as_uint(imp) : 0u; T[q8] = 0u; }
#pragma unroll 1
          for (int bit = 30; bit >= 0; --bit) {
#pragma unroll
              for (int q8 = 0; q8 < 8; ++q8) { const unsigned trial = T[q8] | (1u << bit); const unsigned long long ge = __ballot(key[q8] >= trial) & candm; if (__builtin_popcountll(ge) >= 13) T[q8] = trial; }
          }
#pragma unroll
          for (int q8 = 0; q8 < 8; ++q8) {
              const unsigned long long gt = __ballot(key[q8] > T[q8]) & candm, eq = __ballot(key[q8] == T[q8]) & candm;
              const int take = 13 - __builtin_popcountll(gt);
              const int below = __builtin_popcountll(eq & (lanebit - 1ull));
              const unsigned long long eqsel = __ballot(((eq & lanebit) != 0ull) && below < take);
              const unsigned long long sm = forced | gt | eqsel;
              if (lane == 0) { selw[2 * (8 * wave + q8)] = (unsigned)sm; selw[2 * (8 * wave + q8) + 1] = (unsigned)(sm >> 32); }
          }
      } else if (lane < 8) { selw[2 * (8 * wave + lane)] = (unsigned)valid; selw[2 * (8 * wave + lane) + 1] = (unsigned)(valid >> 32); }
      LDS_WAIT(); asm volatile("" ::: "memory");
      }
    { const float g0_ = FA_GATE(0); if (hi == 0) wsf[r32] = g0_;
      LDS_WAIT(); asm volatile("" ::: "memory");
#pragma unroll
      for (int r = 0; r < 16; ++r) { const int row = crow(r, hi); const float f = wsf[row]; pw[row * 64 + r32] = o[0][r] * f; pw[row * 64 + 32 + r32] = o[1][r] * f; o[0][r] = 0.f; o[1][r] = 0.f; }
      LDS_WAIT(); asm volatile("" ::: "memory"); }
    FA_STAMP(13);
#pragma unroll
    for (int j = 0; j < 3; ++j) if (wcon[j]) { v4u o;
        if (wcI[j].rs) { o.x = cvtpk(wcv[j][0] * wcI[j].rs[0], wcv[j][1] * wcI[j].rs[1]); o.y = cvtpk(wcv[j][2] * wcI[j].rs[2], wcv[j][3] * wcI[j].rs[3]); o.z = cvtpk(wcv[j][4] * wcI[j].rs[4], wcv[j][5] * wcI[j].rs[5]); o.w = cvtpk(wcv[j][6] * wcI[j].rs[6], wcv[j][7] * wcI[j].rs[7]); }
        else { o.x = cvtpk(wcv[j][0], wcv[j][1]); o.y = cvtpk(wcv[j][2], wcv[j][3]); o.z = cvtpk(wcv[j][4], wcv[j][5]); o.w = cvtpk(wcv[j][6], wcv[j][7]); }
        *(v4u*)wcI[j].dst = o; }
    lsum = 0.f;
    f32x16 pA0, pA1, pB0, pB1;
#define FA_SB() __builtin_amdgcn_sched_barrier(0)
#define FA_PIN(x) asm volatile("" : "+v"(x))
#define FA_MASK(C0, C1, i_) do { const bool is_slc_ = ((i_) < i_d); const int j_ = is_slc_ ? ((i_) - i_c) : (qt - ((i_) - i_d)); \
        if ((i_) >= ntile) { _Pragma("unroll") for (int r = 0; r < 16; ++r) { C0[r] = NEGF; C1[r] = NEGF; } } \
        else { if (j_ == qt) { _Pragma("unroll") for (int r = 0; r < 16; ++r) { const int c = (r & 3) + 8 * (r >> 2); if (c > qlm) C0[r] = NEGF; if (c + 32 > qlm) C1[r] = NEGF; } } \
               else if (!is_slc_ && j_ == qt - 8) { _Pragma("unroll") for (int r = 0; r < 16; ++r) { const int c = (r & 3) + 8 * (r >> 2); if (c <= qlm) C0[r] = NEGF; if (c + 32 <= qlm) C1[r] = NEGF; } } \
               if (is_slc_) { const unsigned wsel_ = selw[2 * ql + (j_ >> 5)]; if (!((wsel_ >> (j_ & 31)) & 1u)) { _Pragma("unroll") for (int r = 0; r < 16; ++r) { C0[r] = NEGF; C1[r] = NEGF; } } } } } while (0)
#define FA_FLUSH(gate_) do { const float lt_ = swap_sum(lsum); const float fac_ = (gate_) * __builtin_amdgcn_rcpf(lt_); \
        if (hi == 0) wsf[r32] = fac_; LDS_WAIT(); asm volatile("" ::: "memory"); \
        _Pragma("unroll") for (int r = 0; r < 16; ++r) { const int row = crow(r, hi); const float f_ = wsf[row]; pw[row * 64 + r32] += o[0][r] * f_; pw[row * 64 + 32 + r32] += o[1][r] * f_; o[0][r] = 0.f; o[1][r] = 0.f; } \
        LDS_WAIT(); asm volatile("" ::: "memory"); lsum = 0.f; } while (0)
#define FA_PK(P, B) cvtpk(P[B], P[(B) + 1])
#define FA_GAPA(MF, A0, A1, A2, A3, W0, W1, PW) do { MF; sacc += A0; sacc += A1; sacc += A2; sacc += A3; FA_PIN(sacc); W0; W1; FA_PIN(PW); FA_SB(); } while (0)
#define FA_GAPB(MF, X, B) do { MF; X[B] = __builtin_amdgcn_exp2f(X[B]); X[(B) + 1] = __builtin_amdgcn_exp2f(X[(B) + 1]); X[(B) + 2] = __builtin_amdgcn_exp2f(X[(B) + 2]); X[(B) + 3] = __builtin_amdgcn_exp2f(X[(B) + 3]); FA_PIN(X); FA_SB(); } while (0)
#define FA_VFR(k) (bf16x8){vlo[k][0], vlo[k][1], vlo[k][2], vlo[k][3], vhi[k][0], vhi[k][1], vhi[k][2], vhi[k][3]}
#define FA_KRD(k) kf[k] = *(const LAS bf16x8*)(kb_ + ((k) >> 1) * 2048 + ((k) & 1) * 512)
#define FA_VRD(k) do { vlo[k] = vtr(vb_ + ((k) >> 2) * 4096 + ((k) & 3) * 1024); vhi[k] = vtr(vb_ + ((k) >> 2) * 4096 + ((k) & 3) * 1024 + 512); } while (0)
#define FA_STEP(C0, C1, P0, P1) do { \
        FA_PREFETCH(); \
        const lds_cptr kb_ = kslot + hi * 1024 + r32 * 16; bf16x8 kf[8]; \
        const lds_cptr vb_ = L + L_V + vprev * 8192 + ((lane >> 4) & 1) * 32 + (lane & 3) * 8 + (4 * hi + ((lane & 15) >> 2)) * 64; s16x4 vlo[8], vhi[8]; \
        FA_KRD(0); FA_KRD(1); FA_KRD(2); FA_SB(); \
        v4u pw0, pw1, pw2, pw3; float sacc = P0[0] + P0[1]; \
        FA_KRD(3); FA_GAPA(C0 = FA_MFMA32(kf[0], qr[0], zero16), P0[2], P0[3], P0[4], P0[5],     pw0.x = FA_PK(P0, 0),  pw0.y = FA_PK(P0, 2),  pw0); \
        FA_KRD(4); FA_GAPA(C1 = FA_MFMA32(kf[1], qr[0], zero16), P0[6], P0[7], P0[8], P0[9],     pw0.z = FA_PK(P0, 4),  pw0.w = FA_PK(P0, 6),  pw0); \
        FA_KRD(5); FA_GAPA(C0 = FA_MFMA32(kf[2], qr[1], C0),     P0[10], P0[11], P0[12], P0[13], pw1.x = FA_PK(P0, 8),  pw1.y = FA_PK(P0, 10), pw1); \
        FA_KRD(6); FA_GAPA(C1 = FA_MFMA32(kf[3], qr[1], C1),     P0[14], P0[15], P1[0], P1[1],   pw1.z = FA_PK(P0, 12), pw1.w = FA_PK(P0, 14), pw1); \
        FA_KRD(7); FA_GAPA(C0 = FA_MFMA32(kf[4], qr[2], C0),     P1[2], P1[3], P1[4], P1[5],     pw2.x = FA_PK(P1, 0),  pw2.y = FA_PK(P1, 2),  pw2); \
        FA_VRD(0); FA_GAPA(C1 = FA_MFMA32(kf[5], qr[2], C1),     P1[6], P1[7], P1[8], P1[9],     pw2.z = FA_PK(P1, 4),  pw2.w = FA_PK(P1, 6),  pw2); \
        FA_VRD(4); FA_GAPA(C0 = FA_MFMA32(kf[6], qr[3], C0),     P1[10], P1[11], P1[12], P1[13], pw3.x = FA_PK(P1, 8),  pw3.y = FA_PK(P1, 10), pw3); \
        FA_VRD(1); FA_GAPA(C1 = FA_MFMA32(kf[7], qr[3], C1),     P1[14], P1[15], 0.f, 0.f,       pw3.z = FA_PK(P1, 12), pw3.w = FA_PK(P1, 14), pw3); \
        lsum += sacc; \
        FA_MASK(C0, C1, i); FA_SB(); \
        FA_VRD(5); FA_GAPB(o[0] = FA_MFMA32(__builtin_bit_cast(bf16x8, pw0), FA_VFR(0), o[0]), C0, 0); \
        FA_VRD(2); FA_GAPB(o[1] = FA_MFMA32(__builtin_bit_cast(bf16x8, pw0), FA_VFR(4), o[1]), C0, 4); \
        FA_VRD(6); FA_GAPB(o[0] = FA_MFMA32(__builtin_bit_cast(bf16x8, pw1), FA_VFR(1), o[0]), C0, 8); \
        FA_VRD(3); FA_GAPB(o[1] = FA_MFMA32(__builtin_bit_cast(bf16x8, pw1), FA_VFR(5), o[1]), C0, 12); \
        FA_VRD(7); FA_GAPB(o[0] = FA_MFMA32(__builtin_bit_cast(bf16x8, pw2), FA_VFR(2), o[0]), C1, 0); \
        FA_GAPB(o[1] = FA_MFMA32(__builtin_bit_cast(bf16x8, pw2), FA_VFR(6), o[1]), C1, 4); \
        FA_GAPB(o[0] = FA_MFMA32(__builtin_bit_cast(bf16x8, pw3), FA_VFR(3), o[0]), C1, 8); \
        FA_GAPB(o[1] = FA_MFMA32(__builtin_bit_cast(bf16x8, pw3), FA_VFR(7), o[1]), C1, 12); \
        if (i == i_d) FA_FLUSH(FA_GATE(1));        \
        FA_COMMIT(); } while (0)
    { FA_PREFETCH();
      qkt(pA0, pA1, kslot, qr, zero16, r32, hi);
      FA_MASK(pA0, pA1, i);
#pragma unroll
      for (int r = 0; r < 16; ++r) { pA0[r] = __builtin_amdgcn_exp2f(pA0[r]); pA1[r] = __builtin_amdgcn_exp2f(pA1[r]); }
      FA_COMMIT(); ++i; }
    for (; i < ntile_eff; i += 2) {
        FA_STEP(pB0, pB1, pA0, pA1);
        { ++i; FA_STEP(pA0, pA1, pB0, pB1); --i; }
    }
    { float s = 0.f;
#pragma unroll
      for (int r = 0; r < 16; ++r) s += pA0[r] + pA1[r];
      lsum += s;
      bf16x8 vf[8]; v_load(vf, L + L_V + vprev * 8192, lane, hi);
      pv(o, vf, pA0, pA1);
      FA_FLUSH(FA_GATE(2)); }
#undef FA_GATE
#undef FA_STEP
#undef FA_KRD
#undef FA_VRD
#undef FA_GAPA
#undef FA_GAPB
#undef FA_VFR
#undef FA_PK
#undef FA_MASK
#undef FA_FLUSH
#undef FA_SB
#undef FA_PIN
#undef FA_PREFETCH
#undef FA_COMMIT
    FA_STAMP(14);
    { bf16* ob = C.COMB() + (size_t)(b * 16 + (qt >> 2)) * (256 * 1536) + (size_t)(g * 4) * (256 * 64) + ((qt & 3) * 64 + 8 * wave) * 64;
      int lane_o = lane; asm volatile("" : "+v"(lane_o));
#pragma unroll
      for (int k = 0; k < 4; ++k) { const int idx = k * 64 + lane_o, row = idx >> 3, ch = idx & 7; const f32x4 va = *(const LAS f32x4*)(pw + row * 64 + ch * 8), vb = *(const LAS f32x4*)(pw + row * 64 + ch * 8 + 4);
          v4u v; v.x = cvtpk(va[0], va[1]); v.y = cvtpk(va[2], va[3]); v.z = cvtpk(vb[0], vb[1]); v.w = cvtpk(vb[2], vb[3]);
          *(v4u*)(ob + (size_t)(row & 3) * (256 * 64) + (row >> 2) * 64 + ch * 8) = v; }
      LDS_WAIT(); asm volatile("" ::: "memory"); }
    __syncthreads();
}
#undef FA_MFMA32
}
#ifndef MK_N_LAUNCHES
#define MK_N_LAUNCHES 1
#endif
constexpr int N_PHASES = 8;
#ifndef WGM_P1
#define WGM_P1 4
#endif
#ifndef WGM_P4
#define WGM_P4 4
#endif
#ifndef WGM_P5
#define WGM_P5 4
#endif
#ifndef WGM_P6
#define WGM_P6 8
#endif
#ifndef WGM_P7
#define WGM_P7 4
#endif
#ifdef PROBE_ATTN_CHECK
constexpr size_t PROBE_EXTRA = 0;
#else
constexpr size_t PROBE_EXTRA = 0;
#endif
struct Args { const float* in[24]; float* out; unsigned char* ws; int ph_lo, ph_hi, use_bar, pad; };
__global__ void __launch_bounds__(NWAVES * 64, 2) mega_fwd(Args args) {
    extern __shared__ __attribute__((aligned(16))) unsigned char lds_raw[];
    LAS unsigned char* lds = (LAS unsigned char*)lds_raw;
    Ctx C;
    C.tid = threadIdx.x; C.lane = C.tid & 63; C.wave = __builtin_amdgcn_readfirstlane(C.tid >> 6);
    C.G = gridDim.x; { const int bx = blockIdx.x; C.vcu = (C.G % 8 == 0) ? (bx % 8) * (C.G / 8) + bx / 8 : bx; }
    unsigned char* ws = args.ws;
    C.in = args.in; C.outp = args.out; C.ws = ws;

    for (int u = C.tid; u < (LDS_BYTES - LDSCTL_OFF) / 4; u += NWAVES * 64) ((LAS unsigned*)(lds + LDSCTL_OFF))[u] = 0u;
    __syncthreads();
    gu32* ctl = (gu32*)(ws + WS_CTL);
    XcdBarrier bar; bar.bar = (unsigned*)(ctl + CW_BAR); bar.x = 0; bar.st = nullptr;
    if (args.use_bar) bar = xcd_barrier_post((unsigned*)(ctl + CW_BAR), (volatile LAS unsigned*)(lds + MISC_OFF) + 8);
    const int lo = args.ph_lo, hi = args.ph_hi;
#define IN(k) (lo <= (k) && (k) < hi)
#ifdef ONLY_PHASE
#define PHASE_ON(k) ((k) == ONLY_PHASE)
#else
#define PHASE_ON(k) true
#endif
#ifdef PROBE_TS
#define STAMP(k) do { if (blockIdx.x == 0 && C.tid == 0) ((unsigned long long*)(ctl + 64))[k] = rt(); } while (0)
#else
#define STAMP(k) do {} while (0)
#endif
#define SEAM(k) do { if (IN(k) && IN((k) + 1)) xcd_barrier(bar); STAMP((k) + 1); } while (0)

    STAMP(0);
#ifdef PROBE_START_SKEW
    if (C.tid == 0) ((unsigned long long*)(ctl + 2048))[blockIdx.x] = rt();
#endif
    if (PHASE_ON(0) && IN(0)) { p0_prologue(C, lds); }
    SEAM(0);
    if (PHASE_ON(1) && IN(1)) {
        pg8::Gemm g{C.XN(), C.WIN(), T, NPROJ, DM}; pg8::StaticOrder S; S.init(T, NPROJ, C.G, (int)blockIdx.x, 0, WGM_P1);
        pg8::EpiProj E{C.ws};
        pg8::gemm_phase<pg8::EpiProj, pg8::StaticOrder, true, true>(lds + RING_OFF, g, S, E);
    }
    SEAM(1);
    if (PHASE_ON(2) && IN(2)) {
        for (int s = C.vcu; s < 256; s += C.G) lru_strip(C, s, lds);
        STAMP(9);
        for (int it = C.vcu; it < 256; it += C.G) compress_item(C, it, lds);
        STAMP(10);
        const int gw = C.vcu * NWAVES + C.wave, NGW = C.G * NWAVES;
        (void)gw; (void)NGW;
    }
    SEAM(2);
    if (PHASE_ON(3) && IN(3)) {
#ifdef NAIVE_ATTN
        const int gw = C.vcu * NWAVES + C.wave, NGW = C.G * NWAVES;
        LAS float* wl = (LAS float*)(lds + C.wave * 8192);
        for (int q = gw; q < BATCH * 2 * SEQ; q += NGW) attn_naive(C, q, wl, C.COMB());
#else
        for (int u = C.vcu; u < 1024; u += C.G) { const int bg = (u & 255) >> 4, s = u & 15, k = u >> 8;
            const unsigned long long qlo = (k == 0) ? 0xdb7e39ebbf3dfbfull : (k == 1) ? 0xba37e19a7a64a22ull : (k == 2) ? 0x4dd6d461c5a069eull : 0x18734f143100042ull, qhi = (k == 0) ? 0xc31cb3d35ull : (k == 1) ? 0xb2daea96full : (k == 2) ? 0x4525d5650ull : 0x38c20a2c9ull;
            const int qt = (int)(((s < 10) ? (qlo >> (6 * s)) : (qhi >> (6 * (s - 10)))) & 63ull);
            fa::attn_unit(C, bg >> 1, bg & 1, qt, u / C.G, lds); }
        { const int NW = C.G * NWAVES; const int done = ((1024 + C.G - 1) / C.G) * 3 * NW; WconvItem I;
          for (int idx = done + C.vcu * NWAVES + C.wave; idx < 21504; idx += NW) if (wconv_decode(C, idx, C.lane, I)) { float v[8];
#pragma unroll
              for (int e = 0; e < 8; ++e) v[e] = I.src[(size_t)e * I.ldn] * (I.rs ? I.rs[e] : 1.0f);
              v4u o; o.x = cvtpk2(v[0], v[1]); o.y = cvtpk2(v[2], v[3]); o.z = cvtpk2(v[4], v[5]); o.w = cvtpk2(v[6], v[7]); *(v4u*)I.dst = o; } }
#endif
#ifdef PROBE_ATTN_CHECK
        { const int gw = C.vcu * NWAVES + C.wave, NGW = C.G * NWAVES;
          bf16* o2 = (bf16*)(ws + WS_XR);
          LAS float* wl = (LAS float*)(lds + C.wave * 8192);
          __syncthreads();
          for (int q = gw; q < BATCH * 2 * SEQ; q += NGW) attn_naive(C, q, wl, o2);
          xcd_barrier(bar);
          float md = 0.f; int big = 0;
          for (size_t e = (size_t)(C.vcu * NWAVES * 64 + C.tid); e < (size_t)T * 512; e += (size_t)C.G * NWAVES * 64) { const size_t ee = (e >> 9) * 1536 + (e & 511); const float d = fabsf(bf2f(C.COMB()[ee]) - bf2f(o2[ee])); md = fmaxf(md, d); big += (d > 0.01f) ? 1 : 0; }
          md = wave_max(md);
          if (C.lane == 0) atomicMax((unsigned*)(ctl + 2), __float_as_uint(md));
          atomicAdd((unsigned*)(ctl + 3), (unsigned)big);
        }
#endif
    }
    SEAM(3);
    if (PHASE_ON(4) && IN(4)) {
        pg8::Gemm g{C.COMB(), C.WM(), T, DM, 1536}; pg8::StaticOrder S; S.init(T, DM, C.G, (int)blockIdx.x, 0, WGM_P4);
        pg8::EpiMerge E{C.GM(), C.MERGED()};
        pg8::gemm_phase<pg8::EpiMerge, pg8::StaticOrder, true, true>(lds + RING_OFF, g, S, E);
    }
    SEAM(4);
    if (PHASE_ON(5) && IN(5)) {
        pg8::Gemm g{C.MERGED(), C.WO(), T, DM, DM}; pg8::StaticOrder S; S.init(T, DM, C.G, (int)blockIdx.x, 0, WGM_P5);
        pg8::EpiWo E{C.x(), C.HB(), C.SS()};
        pg8::gemm_phase<pg8::EpiWo, pg8::StaticOrder, true, true>(lds + RING_OFF, g, S, E);
    }
    SEAM(5);
    if (PHASE_ON(6) && IN(6)) {
        pg8::Gemm g{C.HB(), C.W1(), T, DFF, DM}; pg8::StaticOrder S; S.init(T, DFF, C.G, (int)blockIdx.x, 0, WGM_P6);
        pg8::EpiFF1 E{C.SS(), C.U()};
        pg8::gemm_phase<pg8::EpiFF1, pg8::StaticOrder, true, true>(lds + RING_OFF, g, S, E);
    }
    SEAM(6);
    if (PHASE_ON(7) && IN(7)) {
        pg8::Gemm g{C.U(), C.W2(), T, DM, DFF}; pg8::StaticOrder S; S.init(T, DM, C.G, (int)blockIdx.x, 0, WGM_P7);
        pg8::EpiFF2 E{C.HB(), C.out()};
        pg8::gemm_phase<pg8::EpiFF2, pg8::StaticOrder, true, true>(lds + RING_OFF, g, S, E);
    }
#ifdef PROBE_START_SKEW
    xcd_barrier(bar);
    if (blockIdx.x == 0 && C.tid == 0) { const unsigned long long* sp = (const unsigned long long*)(ctl + 2048); unsigned long long mn = ~0ull, mx = 0ull; for (int q = 0; q < (int)gridDim.x; ++q) { const unsigned long long v = sp[q]; mn = v < mn ? v : mn; mx = v > mx ? v : mx; } C.out()[0] += (float)(mx - mn) * 0.001f; }
#endif
#ifdef PROBE_TS
    xcd_barrier(bar); STAMP(8);
    if (blockIdx.x == 0 && C.tid == 0) { VM_WAIT(); const unsigned long long* tsp = (const unsigned long long*)(ctl + 64); C.out()[0] += ((float)(tsp[PROBE_TS_TO] - tsp[PROBE_TS]) * 0.01f - PROBE_OFFSET) * PROBE_SCALE; }
#endif
#ifdef PROBE_ATTN_CHECK
    xcd_barrier(bar);
    if (blockIdx.x == 0 && C.tid == 0) { const float md = __uint_as_float(__hip_atomic_load((unsigned*)(ctl + 2), RLX_AGENT)); const unsigned big = __hip_atomic_load((unsigned*)(ctl + 3), RLX_AGENT);
        C.out()[0] += PROBE_ATTN_CHECK == 1 ? md * 1000.0f : (float)big; }
#endif
#undef IN
#undef SEAM
}

extern "C" void kernel_launch(void* const* d_in, const int* in_sizes, int n_in, void* d_out, int out_size, void* d_ws, size_t ws_size, hipStream_t stream) {
    static int grid = 0;
    if (grid == 0) {
        if (n_in != 24 || in_sizes[0] != T * DM || out_size != T * DM || ws_size < WS_END + PROBE_EXTRA) { fprintf(stderr, "kernel_launch: unexpected shapes (n_in %d, in0 %d, out %d, ws %zu); nothing launched\n", n_in, n_in > 0 ? in_sizes[0] : -1, out_size, ws_size); grid = -1; return; }
        int dev = 0, cus = 0, per_cu = 0;
        if (hipGetDevice(&dev) != hipSuccess || hipDeviceGetAttribute(&cus, hipDeviceAttributeMultiprocessorCount, dev) != hipSuccess) { fprintf(stderr, "kernel_launch: device query failed\n"); grid = -1; return; }
        if (hipFuncSetAttribute((const void*)mega_fwd, hipFuncAttributeMaxDynamicSharedMemorySize, LDS_BYTES) != hipSuccess) { fprintf(stderr, "kernel_launch: hipFuncSetAttribute failed\n"); grid = -1; return; }
        if (hipOccupancyMaxActiveBlocksPerMultiprocessor(&per_cu, (const void*)mega_fwd, NWAVES * 64, LDS_BYTES) != hipSuccess || per_cu < 1) { fprintf(stderr, "kernel_launch: occupancy query says %d blocks per CU\n", per_cu); (void)hipGetLastError(); per_cu = 1; }
        grid = cus;
    }
    if (grid < 0) return;
    if (hipMemsetAsync((char*)d_ws + WS_CTL, 0, CTL_ZERO_BYTES, stream) != hipSuccess) { fprintf(stderr, "kernel_launch: memset failed\n"); return; }
    Args a{};
    for (int i = 0; i < 24; ++i) a.in[i] = (const float*)d_in[i];
    a.out = (float*)d_out; a.ws = (unsigned char*)d_ws;
#if MK_N_LAUNCHES == 1
    a.ph_lo = 0; a.ph_hi = N_PHASES; a.use_bar = 1;
    void* params[] = {&a};
#ifdef PROBE_PLAIN_LAUNCH
    hipLaunchKernelGGL(mega_fwd, dim3(grid), dim3(NWAVES * 64), LDS_BYTES, stream, a); hipError_t e = hipPeekAtLastError(); (void)params;
#else
    hipError_t e = hipLaunchCooperativeKernel((const void*)mega_fwd, dim3(grid), dim3(NWAVES * 64), params, LDS_BYTES, stream);
#endif
    if (e != hipSuccess) fprintf(stderr, "kernel_launch: cooperative launch failed: %s (grid %d)\n", hipGetErrorString(e), grid);
#else
    for (int p = 0; p < N_PHASES; ++p) {
        a.ph_lo = p; a.ph_hi = p + 1; a.use_bar = 0;
        hipLaunchKernelGGL(mega_fwd, dim3(grid), dim3(NWAVES * 64), LDS_BYTES, stream, a);
    }
#endif
}
```
